# Optimizing an MI355X kernel written in HIP

```python
import jax, jax.numpy as jnp
from jax import lax
import numpy as np

D_MODEL = 1024
BATCH = 16
SEQ = 256
DEPTH = 2
DEC_BATCH = 2
DEC_SEQ = 2048
PAST_LEN = 256

GRID_W = 64
D_MIX = 1024
ATTN_HEADS = 8
ATTN_KV_HEADS = 2
ATTN_HEAD_DIM = 64
ATTN_WINDOW = 128
ATTN_BLOCK = 128
ROPE_THETA = 10000.0
MLSTM_HEADS = 4
MLSTM_HEAD_DIM = 64
MLSTM_CHUNK = 64
FORGET_BIAS = 3.0
POOL_GROUPS = 4
POOL_GROUP_DIM = 64
POOL_WINDOWS = (2, 4, 8, 16)
PEER_HEADS = 8
PEER_N_KEYS = 128
PEER_N_EXPERTS = PEER_N_KEYS * PEER_N_KEYS
PEER_QUERY_DIM = 256
PEER_HALF = PEER_QUERY_DIM // 2
PEER_TOPK = 16
PEER_TOKEN_BLOCK = 128
NORM_EPS = 1e-6

ATTN_Q = ATTN_HEADS * ATTN_HEAD_DIM
ATTN_KV = ATTN_KV_HEADS * ATTN_HEAD_DIM
MLSTM_W = MLSTM_HEADS * MLSTM_HEAD_DIM
POOL_W = POOL_GROUPS * POOL_GROUP_DIM
N_GATES = 4 * MLSTM_HEADS
D_IN = ATTN_Q + 2 * ATTN_KV + 4 * MLSTM_W + N_GATES + POOL_W

kernel_name = 'hybrid_dit_mlstm_pool_swa_peer_step'

F32 = jnp.float32


def rmsnorm(x, g):
    xf = x.astype(F32)
    y = xf * lax.rsqrt(jnp.mean(xf * xf, axis=-1, keepdims=True) + NORM_EPS)
    return (y * g.astype(F32)).astype(x.dtype)


def modulation(cond, w_mod, b_mod):
    m = jax.nn.silu(cond) @ w_mod + b_mod
    return tuple(part[..., None, :] for part in jnp.split(m, 6, axis=-1))


def axial_rope(x, row, col):
    half = ATTN_HEAD_DIM // 2
    inv = ROPE_THETA ** (-jnp.arange(0, half, 2, dtype=F32) / half)

    def rot(xa, pos):
        ang = pos.astype(F32)[:, None] * inv[None, :]
        cos = jnp.cos(ang)[None, :, None, :]
        sin = jnp.sin(ang)[None, :, None, :]
        x1, x2 = jnp.split(xa.astype(F32), 2, axis=-1)
        return jnp.concatenate([x1 * cos - x2 * sin, x2 * cos + x1 * sin], axis=-1)

    xr, xc = jnp.split(x, 2, axis=-1)
    return jnp.concatenate([rot(xr, row), rot(xc, col)], axis=-1).astype(x.dtype)


def softmax_with_sink(logits, sink):
    sink_col = jnp.broadcast_to(sink, logits.shape[:-1] + (1,))
    p = jax.nn.softmax(jnp.concatenate([logits, sink_col], axis=-1), axis=-1)
    return p[..., :-1]


def context_attention(q, k, v, sink):
    B, S = q.shape[:2]
    G = ATTN_HEADS // ATTN_KV_HEADS
    nb = S // ATTN_BLOCK
    scale = ATTN_HEAD_DIM ** -0.5
    qb = q.reshape(B, nb, ATTN_BLOCK, ATTN_KV_HEADS, G, ATTN_HEAD_DIM).swapaxes(0, 1)
    sink_l = sink.astype(F32).reshape(ATTN_KV_HEADS, G, 1, 1)

    def block(qi):
        s = jnp.einsum('bqkgd,bskd->bkgqs', qi, k).astype(F32) * scale
        p = softmax_with_sink(s, sink_l)
        return jnp.einsum('bkgqs,bskd->bqkgd', p.astype(v.dtype), v)

    o = lax.map(block, qb)
    return o.swapaxes(0, 1).reshape(B, S, ATTN_Q)


def latent_attention(q, k, v, kc, vc, sink):
    B, L = q.shape[:2]
    G = ATTN_HEADS // ATTN_KV_HEADS
    nb = L // ATTN_BLOCK
    nband = 3 * ATTN_BLOCK
    scale = ATTN_HEAD_DIM ** -0.5
    qb = q.reshape(B, nb, ATTN_BLOCK, ATTN_KV_HEADS, G, ATTN_HEAD_DIM)

    def band(t):
        tp = jnp.pad(t, ((0, 0), (ATTN_BLOCK, ATTN_BLOCK), (0, 0), (0, 0)))
        tp = tp.reshape(B, nb + 2, ATTN_BLOCK, ATTN_KV_HEADS, ATTN_HEAD_DIM)
        return jnp.concatenate([tp[:, :-2], tp[:, 1:-1], tp[:, 2:]], axis=2)

    kb, vb = band(k), band(v)
    blk = jnp.arange(nb)[:, None] * ATTN_BLOCK
    qpos = (blk + jnp.arange(ATTN_BLOCK)[None, :])[:, :, None]
    kpos = (blk - ATTN_BLOCK + jnp.arange(nband)[None, :])[:, None, :]
    valid = (jnp.abs(qpos - kpos) <= ATTN_WINDOW) & (kpos >= 0) & (kpos < L)
    s_band = jnp.einsum('bnqkgd,bnskd->bnkgqs', qb, kb).astype(F32) * scale
    s_band = jnp.where(valid[None, :, None, None], s_band, -jnp.inf)
    s_ctx = jnp.einsum('bnqkgd,bpkd->bnkgqp', qb, kc).astype(F32) * scale
    sink_l = sink.astype(F32).reshape(ATTN_KV_HEADS, G, 1, 1)
    p = softmax_with_sink(jnp.concatenate([s_band, s_ctx], axis=-1), sink_l)
    o = (jnp.einsum('bnkgqs,bnskd->bnqkgd', p[..., :nband].astype(vb.dtype), vb)
         + jnp.einsum('bnkgqp,bpkd->bnqkgd', p[..., nband:].astype(vc.dtype), vc))
    return o.reshape(B, L, ATTN_Q)


def mlstm_chunkwise(q, k, v, ig, lf, init):
    B, H, L, _ = q.shape
    nc = L // MLSTM_CHUNK

    def chunks(t):
        return jnp.moveaxis(t.reshape((B, H, nc, MLSTM_CHUNK) + t.shape[3:]), 2, 0)

    causal = jnp.tril(jnp.ones((MLSTM_CHUNK, MLSTM_CHUNK), bool))

    def step(carry, xs):
        C, n, m = carry
        qc, kc, vc, igc, lfc = xs
        b = jnp.cumsum(lfc, axis=-1)
        dlog = jnp.where(causal, b[..., :, None] - b[..., None, :] + igc[..., None, :], -jnp.inf)
        state_log = b + m[..., None]
        m_t = jnp.maximum(state_log, jnp.max(dlog, axis=-1))
        w = jnp.exp(dlog - m_t[..., None]) * jnp.einsum('bhtd,bhsd->bhts', qc, kc)
        sc = jnp.exp(state_log - m_t)
        num = sc[..., None] * jnp.einsum('bhtd,bhde->bhte', qc, C) + jnp.einsum('bhts,bhse->bhte', w, vc)
        nq = sc * jnp.einsum('bhtd,bhd->bht', qc, n) + jnp.sum(w, axis=-1)
        h = num / jnp.maximum(jnp.abs(nq), jnp.exp(-m_t))[..., None]
        b_last = b[..., -1]
        wlog = b_last[..., None] - b + igc
        m_new = jnp.maximum(b_last + m, jnp.max(wlog, axis=-1))
        decay = jnp.exp(b_last + m - m_new)
        wk = jnp.exp(wlog - m_new[..., None])[..., None] * kc
        C_new = decay[..., None, None] * C + jnp.einsum('bhsd,bhse->bhde', wk, vc)
        n_new = decay[..., None] * n + jnp.sum(wk, axis=2)
        return (C_new, n_new, m_new), h

    final, h = lax.scan(step, init, (chunks(q), chunks(k), chunks(v), chunks(ig), chunks(lf)))
    h = jnp.moveaxis(h, 0, 2).reshape(B, H, L, v.shape[-1])
    return h, final


def mlstm_bidirectional(q, k, v, gates, init_f, init_b):
    ig_f, fg_f, ig_b, fg_b = [jnp.moveaxis(g, -1, 1) for g in jnp.split(gates, 4, axis=-1)]
    h_f, fin_f = mlstm_chunkwise(q, k, v, ig_f, jax.nn.log_sigmoid(fg_f), init_f)

    def flip(t):
        return jnp.flip(t, axis=2)

    h_b, fin_b = mlstm_chunkwise(flip(q), flip(k), flip(v), flip(ig_b), flip(jax.nn.log_sigmoid(fg_b)), init_b)
    return h_f + flip(h_b), fin_f, fin_b


def multiscale_pool(x, pool_w, pool_scale):
    B, L, _ = x.shape
    xf = x.astype(F32)
    cs = jnp.concatenate([jnp.zeros((B, 1, POOL_W), F32), jnp.cumsum(xf, axis=1)], axis=1)
    t = jnp.arange(L)
    outs = []
    for g, w in enumerate(POOL_WINDOWS):
        lo = jnp.clip(t - w // 2, 0, L)
        hi = jnp.clip(t + w // 2, 0, L)
        sl = slice(g * POOL_GROUP_DIM, (g + 1) * POOL_GROUP_DIM)
        mean = (cs[:, hi, sl] - cs[:, lo, sl]) / (hi - lo).astype(F32)[None, :, None]
        outs.append((mean - xf[..., sl]).astype(x.dtype) @ pool_w[g])
    return jnp.concatenate(outs, axis=-1) * pool_scale


def peer_ffn(x, w_q, sub_keys, u_table, v_table):
    B, L, D = x.shape
    T = B * L
    xt = x.reshape(T, D)
    q = (xt @ w_q).reshape(T, PEER_HEADS, 2, PEER_HALF)
    s = jnp.einsum('thcd,hckd->thck', q, sub_keys).astype(F32)
    top_s, top_i = lax.top_k(s, PEER_TOPK)
    cand = (top_s[:, :, 0, :, None] + top_s[:, :, 1, None, :]).reshape(T, PEER_HEADS, PEER_TOPK * PEER_TOPK)
    best_s, best_p = lax.top_k(cand, PEER_TOPK)
    i1 = jnp.take_along_axis(top_i[:, :, 0, :], best_p // PEER_TOPK, axis=-1)
    i2 = jnp.take_along_axis(top_i[:, :, 1, :], best_p % PEER_TOPK, axis=-1)
    expert = i1 * PEER_N_KEYS + i2
    gate = jax.nn.softmax(best_s, axis=-1).astype(x.dtype)
    nblk = T // PEER_TOKEN_BLOCK

    def block(args):
        xb, eb, gb = args
        a = jax.nn.gelu(jnp.einsum('thkd,td->thk', u_table[eb], xb), approximate=False)
        return jnp.einsum('thk,thkd->td', gb * a, v_table[eb])

    out = lax.map(block, (xt.reshape(nblk, PEER_TOKEN_BLOCK, D),
                          expert.reshape(nblk, PEER_TOKEN_BLOCK, PEER_HEADS, PEER_TOPK),
                          gate.reshape(nblk, PEER_TOKEN_BLOCK, PEER_HEADS, PEER_TOPK)))
    return out.reshape(B, L, D)


def mixing_sublayer(h, p, ctx_kv, mlstm_init, rope_pos):
    B, L, _ = h.shape
    sizes = (ATTN_Q, ATTN_KV, ATTN_KV, MLSTM_W, MLSTM_W, MLSTM_W, MLSTM_W, N_GATES, POOL_W)
    offs = []
    acc = 0
    for sz in sizes[:-1]:
        acc += sz
        offs.append(acc)
    q_a, k_a, v_a, q_m, k_m, v_m, o_m, g_m, x_p = jnp.split(h @ p['w_in'], offs, axis=-1)

    qa = q_a.reshape(B, L, ATTN_HEADS, ATTN_HEAD_DIM)
    ka = k_a.reshape(B, L, ATTN_KV_HEADS, ATTN_HEAD_DIM)
    va = v_a.reshape(B, L, ATTN_KV_HEADS, ATTN_HEAD_DIM)
    if ctx_kv is None:
        attn = context_attention(qa, ka, va, p['attn_sink'])
        kv_out = (ka, va)
    else:
        row, col = rope_pos
        attn = latent_attention(axial_rope(qa, row, col), axial_rope(ka, row, col), va,
                                ctx_kv[0], ctx_kv[1], p['attn_sink'])
        kv_out = None

    def heads(t):
        return t.reshape(B, L, MLSTM_HEADS, MLSTM_HEAD_DIM).transpose(0, 2, 1, 3).astype(F32)

    gates = g_m.astype(F32) + p['gate_b'].astype(F32)
    h_m, fin_f, fin_b = mlstm_bidirectional(heads(q_m), heads(k_m) * MLSTM_HEAD_DIM ** -0.5, heads(v_m),
                                            gates, mlstm_init[0], mlstm_init[1])
    h_m = h_m * lax.rsqrt(jnp.mean(h_m * h_m, axis=-1, keepdims=True) + NORM_EPS)
    h_m = h_m.transpose(0, 2, 1, 3).reshape(B, L, MLSTM_W) * p['mlstm_norm_g'].astype(F32)
    mlstm_out = (jax.nn.sigmoid(o_m.astype(F32)) * h_m).astype(h.dtype)

    pool_out = multiscale_pool(x_p, p['pool_w'], p['pool_scale'])

    out = jnp.concatenate([attn, mlstm_out, pool_out], axis=-1) @ p['w_out']
    return out, kv_out, (fin_f, fin_b)


def trunk_layer(x, mods, p, ctx_kv, mlstm_init, rope_pos):
    sh1, sc1, g1, sh2, sc2, g2 = mods
    h = rmsnorm(x, p['norm1_g']) * (1 + sc1) + sh1
    y, kv, fins = mixing_sublayer(h, p, ctx_kv, mlstm_init, rope_pos)
    x = x + g1 * y
    h = rmsnorm(x, p['norm2_g']) * (1 + sc2) + sh2
    x = x + g2 * peer_ffn(h, p['peer_wq'], p['peer_keys'], p['peer_u'], p['peer_v'])
    return x, kv, fins


def setup_inputs(seed: int = 0) -> dict:
    key = jax.random.key(seed)
    ks = jax.random.split(key, 26)

    def nrm(k, shape, s=1.0):
        return s * jax.random.normal(k, shape, F32)

    gate_offset = jnp.repeat(jnp.array([0.0, FORGET_BIAS, 0.0, FORGET_BIAS], F32), MLSTM_HEADS)
    return {
        'x_prompt': nrm(ks[0], (BATCH, SEQ, D_MODEL)),
        'x_sample': nrm(ks[1], (DEC_BATCH, DEC_SEQ, D_MODEL)),
        'cache_k': nrm(ks[2], (DEC_BATCH, DEPTH, PAST_LEN, ATTN_KV_HEADS, ATTN_HEAD_DIM)),
        'cache_v': nrm(ks[3], (DEC_BATCH, DEPTH, PAST_LEN, ATTN_KV_HEADS, ATTN_HEAD_DIM)),
        'state_C': nrm(ks[4], (DEC_BATCH, DEPTH, 2, MLSTM_HEADS, MLSTM_HEAD_DIM, MLSTM_HEAD_DIM), 0.5),
        'state_n': nrm(ks[5], (DEC_BATCH, DEPTH, 2, MLSTM_HEADS, MLSTM_HEAD_DIM), 0.5),
        'state_m': nrm(ks[6], (DEC_BATCH, DEPTH, 2, MLSTM_HEADS)),
        'c': nrm(ks[7], (DEC_BATCH, D_MODEL)),
        'c_ctx': nrm(ks[8], (D_MODEL,)),
        'w_mod': nrm(ks[9], (DEPTH, D_MODEL, 6 * D_MODEL), 0.5 * D_MODEL ** -0.5),
        'b_mod': nrm(ks[10], (DEPTH, 6 * D_MODEL), 0.02),
        'norm1_g': 1.0 + nrm(ks[11], (DEPTH, D_MODEL), 0.05),
        'norm2_g': 1.0 + nrm(ks[12], (DEPTH, D_MODEL), 0.05),
        'w_in': nrm(ks[13], (DEPTH, D_MODEL, D_IN), D_MODEL ** -0.5),
        'gate_b': gate_offset + nrm(ks[14], (DEPTH, N_GATES), 0.1),
        'attn_sink': nrm(ks[15], (DEPTH, ATTN_HEADS)),
        'mlstm_norm_g': 1.0 + nrm(ks[16], (DEPTH, MLSTM_W), 0.05),
        'pool_w': nrm(ks[17], (DEPTH, POOL_GROUPS, POOL_GROUP_DIM, POOL_GROUP_DIM), POOL_GROUP_DIM ** -0.5),
        'pool_scale': 1.0 + nrm(ks[18], (DEPTH, POOL_W), 0.05),
        'w_out': nrm(ks[19], (DEPTH, D_MIX, D_MODEL), D_MIX ** -0.5),
        'peer_wq': nrm(ks[20], (DEPTH, D_MODEL, PEER_HEADS * PEER_QUERY_DIM), D_MODEL ** -0.5),
        'peer_keys': nrm(ks[21], (DEPTH, PEER_HEADS, 2, PEER_N_KEYS, PEER_HALF), PEER_HALF ** -0.5),
        'peer_u': nrm(ks[22], (DEPTH, PEER_N_EXPERTS, D_MODEL), D_MODEL ** -0.5),
        'peer_v': nrm(ks[23], (DEPTH, PEER_N_EXPERTS, D_MODEL), (PEER_HEADS * PEER_TOPK) ** -0.5),
        'final_norm_g': 1.0 + nrm(ks[24], (D_MODEL,), 0.05),
    }


def reference(x_prompt, x_sample, cache_k, cache_v, state_C, state_n, state_m, c, c_ctx,
              w_mod, b_mod, norm1_g, norm2_g, w_in, gate_b, attn_sink, mlstm_norm_g, pool_w, pool_scale,
              w_out, peer_wq, peer_keys, peer_u, peer_v, final_norm_g):
    rows = x_sample.shape[1] // GRID_W
    row = jnp.repeat(jnp.arange(rows), GRID_W)
    col = jnp.tile(jnp.arange(GRID_W), rows)
    B = x_prompt.shape[0]
    zero_state = (jnp.zeros((B, MLSTM_HEADS, MLSTM_HEAD_DIM, MLSTM_HEAD_DIM), F32),
                  jnp.zeros((B, MLSTM_HEADS, MLSTM_HEAD_DIM), F32),
                  jnp.zeros((B, MLSTM_HEADS), F32))
    xp, xs = x_prompt, x_sample
    ks_, vs_, Cs_, ns_, ms_ = [], [], [], [], []
    for l in range(DEPTH):
        p = {'w_in': w_in[l], 'gate_b': gate_b[l], 'attn_sink': attn_sink[l], 'mlstm_norm_g': mlstm_norm_g[l],
             'pool_w': pool_w[l], 'pool_scale': pool_scale[l], 'w_out': w_out[l],
             'norm1_g': norm1_g[l], 'norm2_g': norm2_g[l], 'peer_wq': peer_wq[l], 'peer_keys': peer_keys[l],
             'peer_u': peer_u[l], 'peer_v': peer_v[l]}
        xp, (k_l, v_l), (fin_f, fin_b) = trunk_layer(xp, modulation(c_ctx, w_mod[l], b_mod[l]), p,
                                                      None, (zero_state, zero_state), None)
        ks_.append(k_l)
        vs_.append(v_l)
        Cs_.append(jnp.stack([fin_f[0], fin_b[0]], axis=1))
        ns_.append(jnp.stack([fin_f[1], fin_b[1]], axis=1))
        ms_.append(jnp.stack([fin_f[2], fin_b[2]], axis=1))
        init = tuple((state_C[:, l, d].astype(F32), state_n[:, l, d].astype(F32), state_m[:, l, d].astype(F32))
                     for d in range(2))
        xs, _, _ = trunk_layer(xs, modulation(c, w_mod[l], b_mod[l]), p,
                               (cache_k[:, l], cache_v[:, l]), init, (row, col))
    y_prompt = rmsnorm(xp, final_norm_g)
    y_sample = rmsnorm(xs, final_norm_g)
    return (y_prompt, y_sample, jnp.stack(ks_, axis=1), jnp.stack(vs_, axis=1),
            jnp.stack(Cs_, axis=1), jnp.stack(ns_, axis=1), jnp.stack(ms_, axis=1))
```

```cpp
#include <hip/hip_runtime.h>
#include <hip/hip_cooperative_groups.h>
#include <cstdio>
#include <cstdint>
namespace cg = cooperative_groups;

#ifndef MULTI_LAUNCH
#define MULTI_LAUNCH 0
#endif

typedef unsigned short bf16_t;
using bf16x8 = __attribute__((ext_vector_type(8))) short;
using f32x4 = __attribute__((ext_vector_type(4))) float;
using u32x4 = __attribute__((ext_vector_type(4))) unsigned;
typedef __bf16 bf16x2_t __attribute__((ext_vector_type(2)));
typedef float f32x2 __attribute__((ext_vector_type(2)));
#define DI __device__ __forceinline__

constexpr int T = 8192, TC = 4096;
constexpr int NP = 2048;
constexpr int PC_QA = 0, PC_KA = 512, PC_VA = 640, PC_QM = 768, PC_KM = 1024, PC_VM = 1280, PC_OM = 1536, PC_XP = 1792;
constexpr int LDT = 72;
constexpr float EPS = 1e-6f;

constexpr size_t OUT_YP = 0, OUT_YS = 4194304, OUT_CK = 8388608, OUT_CV = 9437184, OUT_SC = 10485760, OUT_SN = 11534336, OUT_SM = 11550720;

constexpr size_t OFF_WINT = 0;
constexpr size_t OFF_WOUTT = OFF_WINT + 8388608;
constexpr size_t OFF_WQT = OFF_WOUTT + 4194304;
constexpr size_t OFF_KEYS = OFF_WQT + 8388608;
constexpr size_t OFF_WGT = OFF_KEYS + 1048576;
constexpr size_t OFF_MOD = OFF_WGT + 131072;
constexpr size_t OFF_ROPE = OFF_MOD + 147456;
constexpr size_t OFF_X = OFF_ROPE + 8192;
constexpr size_t OFF_H = OFF_X + 33554432;
constexpr size_t OFF_P = OFF_H + 16777216;
constexpr size_t OFF_GATES = OFF_P + 33554432;
constexpr size_t OFF_MIX = OFF_GATES + 524288;
constexpr size_t OFF_QP = OFF_MIX + 16777216;
constexpr size_t OFF_EIDX = OFF_QP + 33554432;
constexpr size_t OFF_EGATE = OFF_EIDX + 4194304;
constexpr size_t OFF_GT = OFF_EGATE + 4194304;
constexpr size_t OFF_CST = OFF_GT + 16777216;
constexpr size_t OFF_NV = OFF_CST + 16777216;
constexpr size_t OFF_NST = OFF_NV + 262144;
constexpr size_t OFF_MLOC = OFF_NST + 262144;
constexpr size_t OFF_BLAST = OFF_MLOC + 4096;
constexpr size_t OFF_MST = OFF_BLAST + 4096;
constexpr size_t OFF_U16 = OFF_MST + 4096;
constexpr size_t OFF_V16 = OFF_U16 + 67108864;
constexpr size_t OFF_BAR = OFF_V16 + 67108864;
constexpr size_t WS_TOTAL = OFF_BAR + 32768;

constexpr int SMEM_BYTES = 48128;

struct Params {
  const float *x_prompt, *x_sample, *cache_k, *cache_v, *state_C, *state_n, *state_m, *c, *c_ctx;
  const float *w_mod, *b_mod, *norm1_g, *norm2_g, *w_in, *gate_b, *attn_sink, *mlstm_norm_g, *pool_w, *pool_scale, *w_out,
      *peer_wq, *peer_keys, *peer_u, *peer_v, *final_norm_g;
  float* out;
  char* ws;
  int phase_lo, phase_hi;
};

DI bf16_t f2bf(float x) { return __builtin_bit_cast(bf16_t, (__bf16)x); }
DI float bf2f(bf16_t b) { return __uint_as_float(((unsigned)b) << 16); }
DI unsigned pack2(float a, float b) { bf16x2_t v = {(__bf16)a, (__bf16)b}; return __builtin_bit_cast(unsigned, v); }
DI float bflo(unsigned u) { return __uint_as_float(u << 16); }
DI float bfhi(unsigned u) { return __uint_as_float(u & 0xffff0000u); }

template <int N> DI float dpp_ror(float v) {
  return __builtin_bit_cast(float, __builtin_amdgcn_update_dpp(0, __builtin_bit_cast(int, v), 0x120 + N, 0xF, 0xF, false));
}
DI float g16_sum(float v) {
  v += dpp_ror<8>(v); v += dpp_ror<4>(v); v += dpp_ror<2>(v); v += dpp_ror<1>(v);
  return v;
}
DI float g16_max(float v) {
  v = fmaxf(v, dpp_ror<8>(v)); v = fmaxf(v, dpp_ror<4>(v)); v = fmaxf(v, dpp_ror<2>(v)); v = fmaxf(v, dpp_ror<1>(v));
  return v;
}
DI float wave_sum(float v) {
  v = g16_sum(v);
  v += __shfl_xor(v, 16); v += __shfl_xor(v, 32);
  return v;
}
DI float wave_max(float v) {
  v = g16_max(v);
  v = fmaxf(v, __shfl_xor(v, 16)); v = fmaxf(v, __shfl_xor(v, 32));
  return v;
}

DI void load8(const bf16_t* p, float (&v)[8]) {
  uint4 r = *(const uint4*)p;
  v[0] = bflo(r.x); v[1] = bfhi(r.x); v[2] = bflo(r.y); v[3] = bfhi(r.y);
  v[4] = bflo(r.z); v[5] = bfhi(r.z); v[6] = bflo(r.w); v[7] = bfhi(r.w);
}
DI void load8(const float* p, float (&v)[8]) {
  float4 a = *(const float4*)p, b = *(const float4*)(p + 4);
  v[0] = a.x; v[1] = a.y; v[2] = a.z; v[3] = a.w; v[4] = b.x; v[5] = b.y; v[6] = b.z; v[7] = b.w;
}
DI uint4 pack8(const float (&v)[8]) {
  uint4 r; r.x = pack2(v[0], v[1]); r.y = pack2(v[2], v[3]); r.z = pack2(v[4], v[5]); r.w = pack2(v[6], v[7]); return r;
}

template <typename ST, bool TRANS>
DI void load_tile(bf16_t* sT, const ST* src, long rstride, float scale, const float* rowscale, int tid) {
  if (!TRANS) {
    const int row = tid >> 2;
    if (sizeof(ST) == 2 && rowscale == nullptr && scale == 1.f) {
#pragma unroll
      for (int pp = 0; pp < 2; ++pp) {
        const int d0 = ((tid & 3) * 2 + pp) * 8;
        *(uint4*)(sT + row * LDT + d0) = *(const uint4*)(src + (long)row * rstride + d0);
      }
      return;
    }
    const float sc = scale * (rowscale ? rowscale[row] : 1.f);
#pragma unroll
    for (int pp = 0; pp < 2; ++pp) {
      const int d0 = ((tid & 3) * 2 + pp) * 8;
      float v[8];
      load8(src + (long)row * rstride + d0, v);
#pragma unroll
      for (int i = 0; i < 8; ++i) v[i] *= sc;
      *(uint4*)(sT + row * LDT + d0) = pack8(v);
    }
  } else {
    const int rp = tid >> 3, dc = tid & 7;
    const float sc0 = scale * (rowscale ? rowscale[2 * rp] : 1.f), sc1 = scale * (rowscale ? rowscale[2 * rp + 1] : 1.f);
    float v0[8], v1[8];
    load8(src + (long)(2 * rp) * rstride + dc * 8, v0);
    load8(src + (long)(2 * rp + 1) * rstride + dc * 8, v1);
#pragma unroll
    for (int i = 0; i < 8; ++i) *(unsigned*)(sT + (dc * 8 + i) * LDT + 2 * rp) = pack2(v0[i] * sc0, v1[i] * sc1);
  }
}

DI void load_tile_rope(bf16_t* sT, const bf16_t* src, long rstride, int pos0, float scale, const float2* ropeT, int tid) {
  const int row = tid >> 2, pp = tid & 3, half = pp >> 1, sub = pp & 1;
  const int d1 = half * 32 + sub * 8, d2 = d1 + 16;
  float x1[8], x2[8], o1[8], o2[8];
  load8(src + (long)row * rstride + d1, x1);
  load8(src + (long)row * rstride + d2, x2);
  const int pos = pos0 + row;
  const int pp_ = half == 0 ? (pos >> 6) : (pos & 63);
#pragma unroll
  for (int i = 0; i < 8; ++i) {
    float2 cs = ropeT[pp_ * 16 + sub * 8 + i];
    o1[i] = (x1[i] * cs.x - x2[i] * cs.y) * scale;
    o2[i] = (x2[i] * cs.x + x1[i] * cs.y) * scale;
  }
  *(uint4*)(sT + row * LDT + d1) = pack8(o1);
  *(uint4*)(sT + row * LDT + d2) = pack8(o2);
}

template <int NT, int KS>
DI void mma_lds(const bf16_t* sA, const bf16_t* sB, f32x4 (&acc)[NT], int lane) {
  const int r = lane & 15, q = lane >> 4;
#pragma unroll
  for (int ks = 0; ks < KS; ++ks) {
    bf16x8 a = *(const bf16x8*)(sA + r * LDT + ks * 32 + q * 8);
#pragma unroll
    for (int nt = 0; nt < NT; ++nt) {
      bf16x8 b = *(const bf16x8*)(sB + (nt * 16 + r) * LDT + ks * 32 + q * 8);
      acc[nt] = __builtin_amdgcn_mfma_f32_16x16x32_bf16(a, b, acc[nt], 0, 0, 0);
    }
  }
}

DI int tok_ci(int row) { return row < TC ? 0 : 1 + ((row - TC) >> 11); }

DI int otid() { int t = (int)threadIdx.x; asm volatile("" : "+v"(t)); return t; }

DI void load_row16(const float* row, int lane, float (&v)[16]) {
  float a[8], b[8];
  load8(row + lane * 16, a);
  load8(row + lane * 16 + 8, b);
#pragma unroll
  for (int i = 0; i < 8; ++i) { v[i] = a[i]; v[8 + i] = b[i]; }
}
DI void store_row16(float* row, int lane, const float (&v)[16]) {
  *(float4*)(row + lane * 16) = make_float4(v[0], v[1], v[2], v[3]);
  *(float4*)(row + lane * 16 + 4) = make_float4(v[4], v[5], v[6], v[7]);
  *(float4*)(row + lane * 16 + 8) = make_float4(v[8], v[9], v[10], v[11]);
  *(float4*)(row + lane * 16 + 12) = make_float4(v[12], v[13], v[14], v[15]);
}

DI void norm_mod_emit(const float (&xv)[16], int lane, const float* g, const float* sc, const float* sh, bf16_t* hrow,
                      const float* WgT, float* gates_row) {
  float ss = 0.f;
#pragma unroll
  for (int i = 0; i < 16; ++i) ss += xv[i] * xv[i];
  ss = wave_sum(ss);
  const float rstd = rsqrtf(ss * (1.f / 1024.f) + EPS);
  float gv[16], scv[16], shv[16], hv[16];
  load_row16(g, lane, gv);
  load_row16(sc, lane, scv);
  load_row16(sh, lane, shv);
#pragma unroll
  for (int i = 0; i < 16; ++i) hv[i] = xv[i] * rstd * gv[i] * (1.f + scv[i]) + shv[i];
  {
    float a[8], b[8];
#pragma unroll
    for (int i = 0; i < 8; ++i) { a[i] = hv[i]; b[i] = hv[8 + i]; }
    *(uint4*)(hrow + lane * 16) = pack8(a);
    *(uint4*)(hrow + lane * 16 + 8) = pack8(b);
  }
  if (WgT) {
    float d[16];
    const float* wg = WgT;
    asm volatile("" : "+s"(wg));
#pragma unroll
    for (int j = 0; j < 16; ++j) {
      float wv[16];
      load_row16(wg + j * 1024, lane, wv);
      float s = 0.f;
#pragma unroll
      for (int i = 0; i < 16; ++i) s += hv[i] * wv[i];
      d[j] = s;
    }
#pragma unroll
    for (int j = 0; j < 8; ++j) {
      const bool up = lane & 32;
      float send = up ? d[j] : d[j + 8], keep = up ? d[j + 8] : d[j];
      d[j] = keep + __shfl_xor(send, 32);
    }
#pragma unroll
    for (int j = 0; j < 4; ++j) {
      const bool up = lane & 16;
      float send = up ? d[j] : d[j + 4], keep = up ? d[j + 4] : d[j];
      d[j] = keep + __shfl_xor(send, 16);
    }
#pragma unroll
    for (int j = 0; j < 2; ++j) {
      const bool up = lane & 8;
      float send = up ? d[j] : d[j + 2], keep = up ? d[j + 2] : d[j];
      d[j] = keep + __shfl_xor(send, 8);
    }
    {
      const bool up = lane & 4;
      float send = up ? d[0] : d[1], keep = up ? d[1] : d[0];
      d[0] = keep + __shfl_xor(send, 4);
    }
    d[0] += __shfl_xor(d[0], 2);
    d[0] += __shfl_xor(d[0], 1);
    if ((lane & 3) == 0) {
      const int j = ((lane & 32) ? 8 : 0) + ((lane & 16) ? 4 : 0) + ((lane & 8) ? 2 : 0) + ((lane & 4) ? 1 : 0);
      gates_row[j] = d[0];
    }
  }
}

DI void transpose_tile(const float* src, int ld_src, int k0, int ncol0, bf16_t* dst  , int nrow0, float* sT, int tid) {
  __syncthreads();
#pragma unroll
  for (int r = 0; r < 16; ++r) {
    const int k = r * 4 + (tid >> 6), n = tid & 63;
    sT[k * 65 + n] = src[(size_t)(k0 + k) * ld_src + ncol0 + n];
  }
  __syncthreads();
#pragma unroll
  for (int r = 0; r < 2; ++r) {
    const int chunk = tid + 256 * r, n = chunk >> 3, kc = chunk & 7;
    float v[8];
#pragma unroll
    for (int i = 0; i < 8; ++i) v[i] = sT[(kc * 8 + i) * 65 + n];
    *(uint4*)(dst + (size_t)(nrow0 + n) * 1024 + k0 + kc * 8) = pack8(v);
  }
}

DI void phase_prologue(const Params& p, char* smem) {
  const int tid = otid();
  float* sT = (float*)smem;
  constexpr int N_TR = 2560, N_WG = 32, N_KEYS = 256, N_MOD = 192, N_ROPE = 1, N_UV = 0;
  constexpr int N_ALL = N_TR + N_WG + N_KEYS + N_MOD + N_ROPE + N_UV;
  for (int it = blockIdx.x; it < N_ALL; it += gridDim.x) {
    int i = it;
    if (i < N_TR) {
      const int l = i / 1280; int j = i % 1280;
      if (j < 512) {
        const int kt = j >> 5, nt = j & 31;
        const int n0 = nt * 64, col0 = n0 < 1792 ? n0 : n0 + 16;
        transpose_tile(p.w_in + (size_t)l * 1024 * 2064, 2064, kt * 64, col0, (bf16_t*)(p.ws + OFF_WINT) + (size_t)l * 2048 * 1024, n0, sT, tid);
      } else if (j < 768) {
        j -= 512; const int kt = j >> 4, nt = j & 15;
        transpose_tile(p.w_out + (size_t)l * 1024 * 1024, 1024, kt * 64, nt * 64, (bf16_t*)(p.ws + OFF_WOUTT) + (size_t)l * 1024 * 1024, nt * 64, sT, tid);
      } else {
        j -= 768; const int kt = j >> 5, nt = j & 31;
        transpose_tile(p.peer_wq + (size_t)l * 1024 * 2048, 2048, kt * 64, nt * 64, (bf16_t*)(p.ws + OFF_WQT) + (size_t)l * 2048 * 1024, nt * 64, sT, tid);
      }
      continue;
    }
    i -= N_TR;
    if (i < N_WG) {
      const int l = i >> 4, j = i & 15;
      float* dst = (float*)(p.ws + OFF_WGT) + (size_t)(l * 16 + j) * 1024;
#pragma unroll
      for (int r = 0; r < 4; ++r) { const int k = tid + 256 * r; dst[k] = p.w_in[((size_t)l * 1024 + k) * 2064 + 1792 + j]; }
      continue;
    }
    i -= N_WG;
    if (i < N_KEYS) {
      const size_t e0 = ((size_t)i * 256 + tid) * 8;
      float v[8]; load8(p.peer_keys + e0, v);
      *(uint4*)((bf16_t*)(p.ws + OFF_KEYS) + e0) = pack8(v);
      continue;
    }
    i -= N_KEYS;
    if (i < N_MOD) {
      const int l = i / 96, chunk = i % 96;
      float* sCond = sT;
      float* sRed = sT + 3072;
      __syncthreads();
      for (int e = tid; e < 3072; e += 256) {
        const int ci = e >> 10, k = e & 1023;
        const float cv = ci == 0 ? p.c_ctx[k] : p.c[(ci - 1) * 1024 + k];
        sCond[e] = cv / (1.f + __expf(-cv));
      }
      __syncthreads();
      const int kq = tid >> 6, cl = tid & 63, col = chunk * 64 + cl;
      float a0 = 0.f, a1 = 0.f, a2 = 0.f;
      const float* wp = p.w_mod + (size_t)l * 1024 * 6144 + col;
#pragma unroll 8
      for (int k = kq * 256; k < kq * 256 + 256; ++k) {
        const float w = wp[(size_t)k * 6144];
        a0 += sCond[k] * w; a1 += sCond[1024 + k] * w; a2 += sCond[2048 + k] * w;
      }
      sRed[(kq * 3 + 0) * 64 + cl] = a0; sRed[(kq * 3 + 1) * 64 + cl] = a1; sRed[(kq * 3 + 2) * 64 + cl] = a2;
      __syncthreads();
      if (tid < 192) {
        const int ci = tid >> 6, c2 = tid & 63;
        float s = 0.f;
#pragma unroll
        for (int q = 0; q < 4; ++q) s += sRed[(q * 3 + ci) * 64 + c2];
        const int cc = chunk * 64 + c2;
        ((float*)(p.ws + OFF_MOD))[(size_t)(l * 3 + ci) * 6144 + cc] = s + p.b_mod[l * 6144 + cc];
      }
      continue;
    }
    i -= N_MOD;
    if (i < N_ROPE) {
      float2* rt = (float2*)(p.ws + OFF_ROPE);
#pragma unroll
      for (int r = 0; r < 4; ++r) {
        const int e = tid + 256 * r, pos = e >> 4, j = e & 15;
        const float inv = powf(10000.f, -(float)j / 16.f);
        float s, c; sincosf((float)pos * inv, &s, &c);
        rt[e] = make_float2(c, s);
      }
      continue;
    }
  }
}

DI void convert_uv_item(const Params& p, int i, int tid) {
      const int tab = i >> 13; const size_t e0 = ((size_t)(i & 8191) * 256 + tid) * 16;
      const float* src = (tab ? p.peer_v : p.peer_u) + e0;
      const float scl = tab ? 64.f : 256.f;
      float v0[8], v1[8];
      load8(src, v0); load8(src + 8, v1);
      uint4 r;
      int w;
      w = 0; w = __builtin_amdgcn_cvt_pk_fp8_f32(v0[0] * scl, v0[1] * scl, w, false); w = __builtin_amdgcn_cvt_pk_fp8_f32(v0[2] * scl, v0[3] * scl, w, true); r.x = (unsigned)w;
      w = 0; w = __builtin_amdgcn_cvt_pk_fp8_f32(v0[4] * scl, v0[5] * scl, w, false); w = __builtin_amdgcn_cvt_pk_fp8_f32(v0[6] * scl, v0[7] * scl, w, true); r.y = (unsigned)w;
      w = 0; w = __builtin_amdgcn_cvt_pk_fp8_f32(v1[0] * scl, v1[1] * scl, w, false); w = __builtin_amdgcn_cvt_pk_fp8_f32(v1[2] * scl, v1[3] * scl, w, true); r.z = (unsigned)w;
      w = 0; w = __builtin_amdgcn_cvt_pk_fp8_f32(v1[4] * scl, v1[5] * scl, w, false); w = __builtin_amdgcn_cvt_pk_fp8_f32(v1[6] * scl, v1[7] * scl, w, true); r.w = (unsigned)w;
      const size_t R = e0 >> 10; const int d0 = (int)(e0 & 1023);
      const size_t dstb = ((((R >> 14) * 8 + (size_t)(d0 >> 7)) * 16384 + (R & 16383)) << 7) + (size_t)(d0 & 127);
      *(uint4*)((unsigned char*)(p.ws + (tab ? OFF_V16 : OFF_U16)) + dstb) = r;
}

DI void deferred_convert(const Params& p, int L, int min_block, int quota, bool drain, char* smem) {
  if ((int)blockIdx.x < min_block) return;
  unsigned* ctr = (unsigned*)(p.ws + OFF_BAR) + 4096 + 64 + L * 64;
  int* sb = (int*)smem;
  const int tid = otid();
  for (;;) {
    __syncthreads();
    if (tid == 0) sb[0] = (int)atomicAdd(ctr, (unsigned)quota);
    __syncthreads();
    const int base = sb[0];
    if (base >= 8192) break;
    const int end = min(base + quota, 8192);
    for (int j = base; j < end; ++j) convert_uv_item(p, (j >> 12) * 8192 + L * 4096 + (j & 4095), tid);
    if (!drain) break;
  }
}

DI void phase_norm(const Params& p, int l, int which) {
  const int lane = otid() & 63, gw = blockIdx.x * 4 + (otid() >> 6), nw = gridDim.x * 4;
  float* X = (float*)(p.ws + OFF_X);
  bf16_t* H = (bf16_t*)(p.ws + OFF_H);
  const float* mod = (const float*)(p.ws + OFF_MOD);
  for (int tok = gw; tok < T; tok += nw) {
    float xv[16];
    const int ci = tok_ci(tok);
    const float* md = mod + (size_t)(l * 3 + ci) * 6144;
    if (which == 0) {
      const float* src = tok < TC ? p.x_prompt + (size_t)tok * 1024 : p.x_sample + (size_t)(tok - TC) * 1024;
      load_row16(src, lane, xv);
      store_row16(X + (size_t)tok * 1024, lane, xv);
      norm_mod_emit(xv, lane, p.norm1_g + l * 1024, md + 1024, md, H + (size_t)tok * 1024,
                    (const float*)(p.ws + OFF_WGT) + (size_t)l * 16 * 1024, (float*)(p.ws + OFF_GATES) + (size_t)tok * 16);
    } else if (which == 1) {
      load_row16(X + (size_t)tok * 1024, lane, xv);
      norm_mod_emit(xv, lane, p.norm2_g + l * 1024, md + 4096, md + 3072, H + (size_t)tok * 1024, nullptr, nullptr);
    } else if (which == 2) {
      load_row16(X + (size_t)tok * 1024, lane, xv);
      norm_mod_emit(xv, lane, p.norm1_g + l * 1024, md + 1024, md, H + (size_t)tok * 1024,
                    (const float*)(p.ws + OFF_WGT) + (size_t)l * 16 * 1024, (float*)(p.ws + OFF_GATES) + (size_t)tok * 16);
    } else {
      load_row16(X + (size_t)tok * 1024, lane, xv);
      float ss = 0.f;
#pragma unroll
      for (int i = 0; i < 16; ++i) ss += xv[i] * xv[i];
      ss = wave_sum(ss);
      const float rstd = rsqrtf(ss * (1.f / 1024.f) + EPS);
      float gv[16];
      load_row16(p.final_norm_g, lane, gv);
#pragma unroll
      for (int i = 0; i < 16; ++i) xv[i] = xv[i] * rstd * gv[i];
      store_row16(p.out + (size_t)tok * 1024, lane, xv);
    }
  }
}

template <int EPI>
DI void phase_gemm(const Params& p, int l, const bf16_t* A, const bf16_t* Bt, int N, char* smem) {
  bf16_t* sA = (bf16_t*)smem;
  bf16_t* sB = sA + 128 * LDT;
  const int tid = otid(), lane = tid & 63, w = tid >> 6, wm = w >> 1, wn = w & 1, r = lane & 15, q = lane >> 4;
  const int ntiles = 64 * (N / 128);
  for (int tile = blockIdx.x; tile < ntiles; tile += gridDim.x) {
    const int tm = tile & 63, tn = tile >> 6;
    const int m0 = tm * 128, n0 = tn * 128;
    f32x4 acc[4][4];
#pragma unroll
    for (int mi = 0; mi < 4; ++mi)
#pragma unroll
      for (int ni = 0; ni < 4; ++ni) acc[mi][ni] = (f32x4){0.f, 0.f, 0.f, 0.f};
    u32x4 ra[4], rb[4];
    const int lrow = tid >> 3, lkc = tid & 7;
    const bf16_t* Ap = A + (size_t)(m0 + lrow) * 1024 + lkc * 8;
    const bf16_t* Bp = Bt + (size_t)(n0 + lrow) * 1024 + lkc * 8;
#pragma unroll
    for (int i = 0; i < 4; ++i) { ra[i] = *(const u32x4*)(Ap + (size_t)i * 32 * 1024); rb[i] = *(const u32x4*)(Bp + (size_t)i * 32 * 1024); }
    __syncthreads();
#pragma unroll
    for (int i = 0; i < 4; ++i) { *(u32x4*)(sA + (lrow + 32 * i) * LDT + lkc * 8) = ra[i]; *(u32x4*)(sB + (lrow + 32 * i) * LDT + lkc * 8) = rb[i]; }
    __syncthreads();
    for (int kt = 0; kt < 16; ++kt) {
      if (kt < 15) {
#pragma unroll
        for (int i = 0; i < 4; ++i) {
          ra[i] = *(const u32x4*)(Ap + (size_t)i * 32 * 1024 + (kt + 1) * 64);
          rb[i] = *(const u32x4*)(Bp + (size_t)i * 32 * 1024 + (kt + 1) * 64);
        }
      }
      __builtin_amdgcn_sched_barrier(0);
#pragma unroll
      for (int ks = 0; ks < 2; ++ks) {
        bf16x8 a[4], b[4];
#pragma unroll
        for (int mi = 0; mi < 4; ++mi) a[mi] = *(const bf16x8*)(sA + (wm * 64 + mi * 16 + r) * LDT + ks * 32 + q * 8);
#pragma unroll
        for (int ni = 0; ni < 4; ++ni) b[ni] = *(const bf16x8*)(sB + (wn * 64 + ni * 16 + r) * LDT + ks * 32 + q * 8);
#pragma unroll
        for (int mi = 0; mi < 4; ++mi)
#pragma unroll
          for (int ni = 0; ni < 4; ++ni) acc[mi][ni] = __builtin_amdgcn_mfma_f32_16x16x32_bf16(b[ni], a[mi], acc[mi][ni], 0, 0, 0);
      }
      __syncthreads();
      if (kt < 15) {
#pragma unroll
        for (int i = 0; i < 4; ++i) { *(u32x4*)(sA + (lrow + 32 * i) * LDT + lkc * 8) = ra[i]; *(u32x4*)(sB + (lrow + 32 * i) * LDT + lkc * 8) = rb[i]; }
        __syncthreads();
      }
    }
#pragma unroll
    for (int mi = 0; mi < 4; ++mi) {
      const int row = m0 + wm * 64 + mi * 16 + r;
#pragma unroll
      for (int ni = 0; ni < 4; ++ni) {
        const int col = n0 + wn * 64 + ni * 16 + q * 4;
        const f32x4 v = acc[mi][ni];
        if (EPI == 0) {
          *(uint2*)((bf16_t*)(p.ws + OFF_P) + (size_t)row * NP + col) = make_uint2(pack2(v[0], v[1]), pack2(v[2], v[3]));
          if (row < TC && col >= 512 && col < 768) {
            const int b = row >> 8, s = row & 255, isv = col >= 640, cc = col - (isv ? 640 : 512);
            *(float4*)(p.out + (isv ? OUT_CV : OUT_CK) + ((size_t)(b * 2 + l) * 256 + s) * 128 + cc) = make_float4(v[0], v[1], v[2], v[3]);
          }
        } else if (EPI == 1) {
          const float4 g1 = *(const float4*)((const float*)(p.ws + OFF_MOD) + (size_t)(l * 3 + tok_ci(row)) * 6144 + 2048 + col);
          float4* xp = (float4*)((float*)(p.ws + OFF_X) + (size_t)row * 1024 + col);
          float4 xv = *xp;
          xv.x += g1.x * v[0]; xv.y += g1.y * v[1]; xv.z += g1.z * v[2]; xv.w += g1.w * v[3];
          *xp = xv;
        } else {
          *(uint2*)((bf16_t*)(p.ws + OFF_QP) + (size_t)row * 2048 + col) = make_uint2(pack2(v[0], v[1]), pack2(v[2], v[3]));
        }
      }
    }
  }
}

DI void attn_item(const Params& p, int l, int item, char* smem) {
  bf16_t* sQ = (bf16_t*)smem;
  bf16_t* sK = sQ + 64 * LDT;
  bf16_t* sVt = sK + 64 * LDT;
  bf16_t* sP = sVt + 64 * LDT;
  const int tid = otid(), lane = tid & 63, w = tid >> 6, r = lane & 15, q = lane >> 4;
  const bool lat = item < 512;
  int b, h, qb, L, rowbase;
  if (lat) { b = item >> 8; h = (item >> 5) & 7; qb = item & 31; L = 2048; rowbase = TC + b * 2048; }
  else { const int it = item - 512; b = it >> 5; h = (it >> 2) & 7; qb = it & 3; L = 256; rowbase = b * 256; }
  const int kv = h >> 2, q0 = qb * 64;
  const bf16_t* P = (const bf16_t*)(p.ws + OFF_P);
  const float2* ropeT = (const float2*)(p.ws + OFF_ROPE);
  __syncthreads();
  if (lat) load_tile_rope(sQ, P + (size_t)(rowbase + q0) * NP + PC_QA + h * 64, NP, q0, 0.125f, ropeT, tid);
  else load_tile<bf16_t, false>(sQ, P + (size_t)(rowbase + q0) * NP + PC_QA + h * 64, NP, 0.125f, nullptr, tid);
  const float sink = p.attn_sink[l * 8 + h];
  __syncthreads();
  bf16x8 qf[2];
  qf[0] = *(const bf16x8*)(sQ + (w * 16 + r) * LDT + q * 8);
  qf[1] = *(const bf16x8*)(sQ + (w * 16 + r) * LDT + 32 + q * 8);
  float m_ = sink, l_ = (q == 0) ? 1.f : 0.f;
  f32x4 o[4];
#pragma unroll
  for (int et = 0; et < 4; ++et) o[et] = (f32x4){0.f, 0.f, 0.f, 0.f};
  const int nkt = lat ? 9 : 4;
  const int qp = q0 + w * 16 + r;
  for (int kt = 0; kt < nkt; ++kt) {
    int kpos0; bool band = false, cache = false;
    if (!lat) kpos0 = kt * 64;
    else if (kt < 5) { kpos0 = q0 - 128 + kt * 64; band = true; if (kpos0 < 0 || kpos0 >= L) continue; }
    else { cache = true; kpos0 = (kt - 5) * 64; }
    __syncthreads();
    if (cache) {
      const size_t off = (((size_t)(b * 2 + l) * 256 + kpos0) * 2 + kv) * 64;
      load_tile<float, false>(sK, p.cache_k + off, 128, 1.f, nullptr, tid);
      load_tile<float, true>(sVt, p.cache_v + off, 128, 1.f, nullptr, tid);
    } else {
      const bf16_t* ks = P + (size_t)(rowbase + kpos0) * NP + PC_KA + kv * 64;
      if (lat) load_tile_rope(sK, ks, NP, kpos0, 1.f, ropeT, tid);
      else load_tile<bf16_t, false>(sK, ks, NP, 1.f, nullptr, tid);
      load_tile<bf16_t, true>(sVt, P + (size_t)(rowbase + kpos0) * NP + PC_VA + kv * 64, NP, 1.f, nullptr, tid);
    }
    __syncthreads();
    f32x4 sc[4];
#pragma unroll
    for (int nt = 0; nt < 4; ++nt) {
      sc[nt] = (f32x4){0.f, 0.f, 0.f, 0.f};
#pragma unroll
      for (int ks = 0; ks < 2; ++ks) {
        const bf16x8 kf = *(const bf16x8*)(sK + (nt * 16 + r) * LDT + ks * 32 + q * 8);
        sc[nt] = __builtin_amdgcn_mfma_f32_16x16x32_bf16(kf, qf[ks], sc[nt], 0, 0, 0);
      }
    }
    if (band) {
#pragma unroll
      for (int nt = 0; nt < 4; ++nt)
#pragma unroll
        for (int jj = 0; jj < 4; ++jj) {
          const int d = qp - (kpos0 + nt * 16 + q * 4 + jj);
          if (d > 128 || d < -128) sc[nt][jj] = -INFINITY;
        }
    }
    float mx = -INFINITY;
#pragma unroll
    for (int nt = 0; nt < 4; ++nt)
#pragma unroll
      for (int jj = 0; jj < 4; ++jj) mx = fmaxf(mx, sc[nt][jj]);
    mx = fmaxf(mx, __shfl_xor(mx, 16));
    mx = fmaxf(mx, __shfl_xor(mx, 32));
    const float mn = fmaxf(m_, mx);
    const float alpha = __expf(m_ - mn);
    m_ = mn;
    float ps = 0.f;
    float pv[4][4];
#pragma unroll
    for (int nt = 0; nt < 4; ++nt)
#pragma unroll
      for (int jj = 0; jj < 4; ++jj) { pv[nt][jj] = __expf(sc[nt][jj] - mn); ps += pv[nt][jj]; }
    l_ = l_ * alpha + ps;
#pragma unroll
    for (int et = 0; et < 4; ++et) o[et] *= alpha;
#pragma unroll
    for (int ks = 0; ks < 2; ++ks) {
      u32x4 pk;
      pk[0] = pack2(pv[2 * ks][0], pv[2 * ks][1]); pk[1] = pack2(pv[2 * ks][2], pv[2 * ks][3]);
      pk[2] = pack2(pv[2 * ks + 1][0], pv[2 * ks + 1][1]); pk[3] = pack2(pv[2 * ks + 1][2], pv[2 * ks + 1][3]);
      const bf16x8 pf = __builtin_bit_cast(bf16x8, pk);
#pragma unroll
      for (int et = 0; et < 4; ++et) {
        const bf16_t* vrow = sVt + (et * 16 + r) * LDT + ks * 32 + q * 4;
        const uint2 v0 = *(const uint2*)(vrow), v1 = *(const uint2*)(vrow + 16);
        u32x4 vk; vk[0] = v0.x; vk[1] = v0.y; vk[2] = v1.x; vk[3] = v1.y;
        o[et] = __builtin_amdgcn_mfma_f32_16x16x32_bf16(__builtin_bit_cast(bf16x8, vk), pf, o[et], 0, 0, 0);
      }
    }
  }
  float lt = l_;
  lt += __shfl_xor(lt, 16);
  lt += __shfl_xor(lt, 32);
  const float inv = 1.f / lt;
  bf16_t* mix = (bf16_t*)(p.ws + OFF_MIX);
  const size_t row = rowbase + qp;
#pragma unroll
  for (int et = 0; et < 4; ++et)
    *(uint2*)(mix + row * 1024 + h * 64 + et * 16 + q * 4) = make_uint2(pack2(o[et][0] * inv, o[et][1] * inv), pack2(o[et][2] * inv, o[et][3] * inv));
}

DI float logsigmoid(float x) { return fminf(x, 0.f) - log1pf(__expf(-fabsf(x))); }

struct MItem { int b, h, dir, c, nc, rowbase; bool lat; };
DI MItem mitem_decode(int item) {
  MItem m;
  if (item < 512) { const int seq = item >> 2; m.c = item & 3; m.b = seq >> 3; m.h = (seq >> 1) & 3; m.dir = seq & 1; m.nc = 4; m.rowbase = m.b * 256; m.lat = false; }
  else { const int it = item - 512, s2 = it >> 5; m.c = it & 31; m.b = s2 >> 3; m.h = (s2 >> 1) & 3; m.dir = s2 & 1; m.nc = 32; m.rowbase = TC + m.b * 2048; m.lat = true; }
  return m;
}

DI void chunk_gates(const Params& p, int l, int row0, int h, int dir, int lane, float& bt, float& ig, float& tot) {
  const float* g = (const float*)(p.ws + OFF_GATES) + (size_t)(row0 + lane) * 16;
  ig = g[dir * 8 + h] + p.gate_b[l * 16 + dir * 8 + h];
  const float fg = g[dir * 8 + 4 + h] + p.gate_b[l * 16 + dir * 8 + 4 + h];
  const float lf = logsigmoid(fg);
  float pre = lf;
#pragma unroll
  for (int d = 1; d < 64; d <<= 1) { const float t = __shfl_up(pre, d); if (lane >= d) pre += t; }
  tot = __shfl(pre, 63);
  bt = dir ? (tot - pre + lf) : pre;
}

DI void mlstm_local_item(const Params& p, int l, int item, char* smem) {
  bf16_t* sKat = (bf16_t*)smem;
  bf16_t* sVt = sKat + 64 * LDT;
  float* sa = (float*)(sVt + 64 * LDT);
  const int tid = otid(), lane = tid & 63, w = tid >> 6, r = lane & 15, q = lane >> 4;
  const MItem m = mitem_decode(item);
  const int c_o = m.dir ? m.nc - 1 - m.c : m.c;
  const int row0 = m.rowbase + c_o * 64;
  const bf16_t* P = (const bf16_t*)(p.ws + OFF_P);
  __syncthreads();
  if (w == 0) {
    float bt, ig, tot;
    chunk_gates(p, l, row0, m.h, m.dir, lane, bt, ig, tot);
    const float wlog = tot - bt + ig;
    const float mloc = wave_max(wlog);
    sa[lane] = __expf(wlog - mloc);
    if (lane == 0) { ((float*)(p.ws + OFF_MLOC))[item] = mloc; ((float*)(p.ws + OFF_BLAST))[item] = tot; }
  }
  __syncthreads();
  load_tile<bf16_t, true>(sKat, P + (size_t)row0 * NP + PC_KM + m.h * 64, NP, 0.125f, sa, tid);
  load_tile<bf16_t, true>(sVt, P + (size_t)row0 * NP + PC_VM + m.h * 64, NP, 1.f, nullptr, tid);
  __syncthreads();
  f32x4 acc[4];
#pragma unroll
  for (int nt = 0; nt < 4; ++nt) acc[nt] = (f32x4){0.f, 0.f, 0.f, 0.f};
  mma_lds<4, 2>(sVt + w * 16 * LDT, sKat, acc, lane);
  float* Gt = (float*)(p.ws + OFF_GT) + (size_t)item * 4096;
#pragma unroll
  for (int nt = 0; nt < 4; ++nt)
#pragma unroll
    for (int j = 0; j < 4; ++j) Gt[(w * 16 + q * 4 + j) * 64 + nt * 16 + r] = acc[nt][j];
  if (tid < 64) {
    float s = 0.f;
    for (int i = 0; i < 64; ++i) s += bf2f(sKat[tid * LDT + i]);
    ((float*)(p.ws + OFF_NV))[item * 64 + tid] = s;
  }
}

DI void pool_item(const Params& p, int l, int item, char* smem) {
  float* sX = (float*)smem;
  bf16_t* sD = (bf16_t*)(smem + 20480);
  bf16_t* sWt = sD + 64 * LDT;
  const int tid = otid(), lane = tid & 63, w = tid >> 6, r = lane & 15, q = lane >> 4;
  const int tt = item >> 2, g = item & 3;
  const int row0 = tt * 64;
  const int L = row0 < TC ? 256 : 2048;
  const int pos0 = row0 < TC ? (row0 & 255) : ((row0 - TC) & 2047);
  const bf16_t* P = (const bf16_t*)(p.ws + OFF_P);
  __syncthreads();
  for (int ch = tid; ch < 640; ch += 256) {
    const int rr = ch >> 3, dc = ch & 7;
    const int pos = pos0 - 8 + rr;
    float v[8];
    if (pos >= 0 && pos < L) load8(P + (size_t)(row0 - 8 + rr) * NP + PC_XP + g * 64 + dc * 8, v);
    else {
#pragma unroll
      for (int i = 0; i < 8; ++i) v[i] = 0.f;
    }
#pragma unroll
    for (int i = 0; i < 8; ++i) sX[rr * 64 + dc * 8 + i] = v[i];
  }
  {
    const float* pw = p.pool_w + (size_t)(l * 4 + g) * 4096;
#pragma unroll
    for (int rr = 0; rr < 8; ++rr) { const int in0 = 2 * ((tid >> 6) + 4 * rr), out = tid & 63; *(unsigned*)(sWt + out * LDT + in0) = pack2(pw[in0 * 64 + out], pw[(in0 + 1) * 64 + out]); }
  }
  __syncthreads();
  const int hw = 1 << g;
  {
    const int ch = tid & 63, i0 = (tid >> 6) * 16;
    int pos = pos0 + i0;
    int lo = max(pos - hw, 0), hi = min(pos + hw, L);
    float sum = 0.f;
    for (int u = lo; u < hi; ++u) sum += sX[(u - pos0 + 8) * 64 + ch];
#pragma unroll 4
    for (int rr = 0; rr < 16; ++rr) {
      const int i = i0 + rr;
      sD[i * LDT + ch] = f2bf(sum / (float)(hi - lo) - sX[(i + 8) * 64 + ch]);
      const int lo2 = max(pos + 1 - hw, 0), hi2 = min(pos + 1 + hw, L);
      if (hi2 > hi) sum += sX[(hi2 - 1 - pos0 + 8) * 64 + ch];
      if (lo2 > lo) sum -= sX[(lo - pos0 + 8) * 64 + ch];
      lo = lo2; hi = hi2; ++pos;
    }
  }
  __syncthreads();
  f32x4 acc[4];
#pragma unroll
  for (int nt = 0; nt < 4; ++nt) acc[nt] = (f32x4){0.f, 0.f, 0.f, 0.f};
  mma_lds<4, 2>(sD + w * 16 * LDT, sWt, acc, lane);
  bf16_t* mix = (bf16_t*)(p.ws + OFF_MIX);
#pragma unroll
  for (int nt = 0; nt < 4; ++nt) {
    const int oc = nt * 16 + r;
    const float ps = p.pool_scale[l * 256 + g * 64 + oc];
#pragma unroll
    for (int j = 0; j < 4; ++j) mix[(size_t)(row0 + w * 16 + q * 4 + j) * 1024 + 768 + g * 64 + oc] = f2bf(acc[nt][j] * ps);
  }
}

DI void phase_mixers(const Params& p, int l, char* smem) {
  constexpr int N_LAT = 512, N_ATT = 1024, N_ML = 1024, N_POOL = 512;
  const int G = gridDim.x, bid = blockIdx.x;
  const int Gl = G >= 3 ? (G * 2) / 3 : G;
  if (Gl == G) { for (int it = bid; it < N_ATT; it += G) attn_item(p, l, it, smem); }
  else if (bid < Gl) { for (int it = bid; it < N_LAT; it += Gl) attn_item(p, l, it, smem); }
  else { for (int it = N_LAT + (bid - Gl); it < N_ATT; it += G - Gl) attn_item(p, l, it, smem); }
  for (int it = bid; it < N_ML; it += G) mlstm_local_item(p, l, it, smem);
  for (int it = (bid + 2 * G - 256) % G; it < N_POOL; it += G) pool_item(p, l, it, smem);
}

DI void phase_scan(const Params& p, int l) {
  const int tid = otid();
  const float* Gt = (const float*)(p.ws + OFF_GT);
  const float* NV = (const float*)(p.ws + OFF_NV);
  const float* MLOC = (const float*)(p.ws + OFF_MLOC);
  const float* BL = (const float*)(p.ws + OFF_BLAST);
  float* CST = (float*)(p.ws + OFF_CST);
  float* NST = (float*)(p.ws + OFF_NST);
  float* MST = (float*)(p.ws + OFF_MST);
  for (int it = blockIdx.x; it < 144 * 17; it += gridDim.x) {
    const int seq = it / 17, part = it % 17;
    const bool isC = part < 16;
    if (!isC && tid >= 64) continue;
    const bool lat = seq >= 128;
    int b, h, dir, nc, itembase;
    if (!lat) { b = seq >> 3; h = (seq >> 1) & 3; dir = seq & 1; nc = 4; itembase = seq * 4; }
    else { const int s2 = seq - 128; b = s2 >> 3; h = (s2 >> 1) & 3; dir = s2 & 1; nc = 32; itembase = 512 + s2 * 32; }
    const int idx = part * 256 + tid, e = idx >> 6, d = isC ? (idx & 63) : tid;
    float m = 0.f, val = 0.f;
    if (lat) {
      const size_t sb = ((size_t)(b * 2 + l) * 2 + dir) * 4 + h;
      m = p.state_m[sb];
      val = isC ? p.state_C[(sb * 64 + d) * 64 + e] : p.state_n[sb * 64 + d];
    }
    for (int c0 = 0; c0 < nc; c0 += 4) {
      float g[4], ml[4], bl4[4];
#pragma unroll
      for (int u = 0; u < 4; ++u) {
        const int item = itembase + c0 + u;
        ml[u] = MLOC[item]; bl4[u] = BL[item];
        g[u] = isC ? Gt[(size_t)item * 4096 + idx] : NV[item * 64 + d];
      }
#pragma unroll
      for (int u = 0; u < 4; ++u) {
        const int item = itembase + c0 + u;
        if (isC) { CST[(size_t)item * 4096 + idx] = val; if (idx == 0) MST[item] = m; }
        else NST[item * 64 + d] = val;
        const float mn = fmaxf(bl4[u] + m, ml[u]);
        const float decay = __expf(bl4[u] + m - mn), sc = __expf(ml[u] - mn);
        val = decay * val + sc * g[u];
        m = mn;
      }
    }
    if (!lat) {
      const size_t sb = ((size_t)(b * 2 + l) * 2 + dir) * 4 + h;
      if (isC) { p.out[OUT_SC + (sb * 64 + d) * 64 + e] = val; if (idx == 0) p.out[OUT_SM + sb] = m; }
      else p.out[OUT_SN + sb * 64 + d] = val;
    }
  }
}

DI void phase_mlstm_out(const Params& p, int l, char* smem) {
  bf16_t* sQ = (bf16_t*)smem;
  bf16_t* sK = sQ + 64 * LDT;
  bf16_t* sVt = sK + 64 * LDT;
  bf16_t* sCt = sVt + 64 * LDT;
  bf16_t* sW = sCt + 64 * LDT;
  float* sn = (float*)(sW + 64 * LDT);
  float* sb = sn + 64;
  float* sig = sb + 64;
  const int tid = otid(), lane = tid & 63, w = tid >> 6, r = lane & 15, q = lane >> 4;
  const bf16_t* P = (const bf16_t*)(p.ws + OFF_P);
  bf16_t* sWw = sW + w * 16 * LDT;
  for (int item = blockIdx.x; item < 512; item += gridDim.x) {
    int b, h, c_o, nc, rowbase; bool lat = item < 256;
    if (lat) { b = item >> 7; h = (item >> 5) & 3; c_o = item & 31; nc = 32; rowbase = TC + b * 2048; }
    else { const int it = item - 256; b = it >> 4; h = (it >> 2) & 3; c_o = it & 3; nc = 4; rowbase = b * 256; }
    const int row0 = rowbase + c_o * 64;
    f32x4 hacc[4];
#pragma unroll
    for (int nt = 0; nt < 4; ++nt) hacc[nt] = (f32x4){0.f, 0.f, 0.f, 0.f};
    for (int dir = 0; dir < 2; ++dir) {
      const int cc = dir ? nc - 1 - c_o : c_o;
      const int sitem = lat ? 512 + (b * 8 + h * 2 + dir) * 32 + cc : (b * 8 + h * 2 + dir) * 4 + cc;
      __syncthreads();
      if (w == 0) {
        float bt, ig, tot;
        chunk_gates(p, l, row0, h, dir, lane, bt, ig, tot);
        sb[lane] = bt; sig[lane] = ig;
      }
      if (dir == 0) {
        load_tile<bf16_t, false>(sQ, P + (size_t)row0 * NP + PC_QM + h * 64, NP, 1.f, nullptr, tid);
        load_tile<bf16_t, false>(sK, P + (size_t)row0 * NP + PC_KM + h * 64, NP, 0.125f, nullptr, tid);
        load_tile<bf16_t, true>(sVt, P + (size_t)row0 * NP + PC_VM + h * 64, NP, 1.f, nullptr, tid);
      }
      float m0 = 0.f;
      {
        const int itembase = sitem - cc;
        const size_t sbi = ((size_t)(b * 2 + l) * 2 + dir) * 4 + h;
        const int e_ = tid >> 2;
        const float* Gt = (const float*)(p.ws + OFF_GT);
        const float* NV = (const float*)(p.ws + OFF_NV);
        const float* MLOC = (const float*)(p.ws + OFF_MLOC);
        const float* BL = (const float*)(p.ws + OFF_BLAST);
        const int nsteps = (!lat && cc == nc - 1) ? nc : cc;
#pragma unroll 1
        for (int half = 0; half < 2; ++half) {
          const int dq = (tid & 3) * 16 + half * 8;
          float val[8], nval = 0.f, m = 0.f;
#pragma unroll
          for (int i = 0; i < 8; ++i) val[i] = 0.f;
          if (lat) {
            m = p.state_m[sbi];
#pragma unroll
            for (int i = 0; i < 8; ++i) val[i] = p.state_C[(sbi * 64 + dq + i) * 64 + e_];
            if (half == 0 && tid < 64) nval = p.state_n[sbi * 64 + tid];
          }
          for (int c0 = 0; c0 < cc; c0 += 4) {
            float g4[4][8], ml4[4], bl4[4], nv4[4];
#pragma unroll
            for (int u = 0; u < 4; ++u) {
              const int it2 = itembase + min(c0 + u, cc - 1);
              ml4[u] = MLOC[it2]; bl4[u] = BL[it2];
              load8(Gt + (size_t)it2 * 4096 + e_ * 64 + dq, g4[u]);
              nv4[u] = (half == 0 && tid < 64) ? NV[it2 * 64 + tid] : 0.f;
            }
#pragma unroll
            for (int u = 0; u < 4; ++u) {
              if (c0 + u < cc) {
                const float mn = fmaxf(bl4[u] + m, ml4[u]);
                const float decay = __expf(bl4[u] + m - mn), sc = __expf(ml4[u] - mn);
#pragma unroll
                for (int i = 0; i < 8; ++i) val[i] = decay * val[i] + sc * g4[u][i];
                nval = decay * nval + sc * nv4[u];
                m = mn;
              }
            }
          }
          *(uint4*)(sCt + e_ * LDT + dq) = pack8(val);
          if (half == 0 && tid < 64) sn[tid] = nval;
          m0 = m;
          if (nsteps != cc) {
            const int it2 = itembase + cc;
            const float mloc = MLOC[it2], bl = BL[it2];
            const float mn = fmaxf(bl + m, mloc);
            const float decay = __expf(bl + m - mn), sc = __expf(mloc - mn);
            float g0[8];
            load8(Gt + (size_t)it2 * 4096 + e_ * 64 + dq, g0);
#pragma unroll
            for (int i = 0; i < 8; ++i) val[i] = decay * val[i] + sc * g0[i];
            if (half == 0 && tid < 64) nval = decay * nval + sc * NV[it2 * 64 + tid];
            m = mn;
          }
          if (nsteps != cc) {
#pragma unroll
            for (int i = 0; i < 8; ++i) p.out[OUT_SC + (sbi * 64 + dq + i) * 64 + e_] = val[i];
            if (half == 0 && tid < 64) p.out[OUT_SN + sbi * 64 + tid] = nval;
            if (half == 0 && tid == 0) p.out[OUT_SM + sbi] = m;
          }
        }
      }
      __syncthreads();
      f32x4 s[4], qc[4], wv[4];
#pragma unroll
      for (int nt = 0; nt < 4; ++nt) { s[nt] = (f32x4){0.f, 0.f, 0.f, 0.f}; qc[nt] = s[nt]; wv[nt] = s[nt]; }
      mma_lds<4, 2>(sQ + w * 16 * LDT, sK, s, lane);
      mma_lds<4, 2>(sQ + w * 16 * LDT, sCt, qc, lane);
      float qn_r;
      {
        float acc = 0.f;
        const bf16_t* qr = sQ + (w * 16 + r) * LDT + q * 16;
#pragma unroll
        for (int i = 0; i < 16; ++i) acc += bf2f(qr[i]) * sn[q * 16 + i];
        acc += __shfl_xor(acc, 16);
        acc += __shfl_xor(acc, 32);
        qn_r = acc;
      }
      float scj[4], denj[4];
#pragma unroll
      for (int j = 0; j < 4; ++j) {
        const int t = w * 16 + q * 4 + j;
        const float btt = sb[t];
        float dl[4];
        float mx = -INFINITY;
#pragma unroll
        for (int nt = 0; nt < 4; ++nt) {
          const int si = nt * 16 + r;
          const bool valid = dir ? (si >= t) : (si <= t);
          dl[nt] = valid ? (btt - sb[si] + sig[si]) : -INFINITY;
          mx = fmaxf(mx, dl[nt]);
        }
        mx = g16_max(mx);
        const float mrow = fmaxf(btt + m0, mx);
        float rs = 0.f;
#pragma unroll
        for (int nt = 0; nt < 4; ++nt) {
          const float wv_ = __expf(dl[nt] - mrow) * s[nt][j];
          rs += wv_;
          sWw[(q * 4 + j) * LDT + nt * 16 + r] = f2bf(wv_);
        }
        rs = g16_sum(rs);
        const float sc = __expf(btt + m0 - mrow);
        const float qn = __shfl(qn_r, q * 4 + j);
        scj[j] = sc;
        denj[j] = fmaxf(fabsf(sc * qn + rs), __expf(-mrow));
      }
      mma_lds<4, 2>(sWw, sVt, wv, lane);
#pragma unroll
      for (int nt = 0; nt < 4; ++nt)
#pragma unroll
        for (int j = 0; j < 4; ++j) hacc[nt][j] += (scj[j] * qc[nt][j] + wv[nt][j]) / denj[j];
    }
    bf16_t* mix = (bf16_t*)(p.ws + OFF_MIX);
#pragma unroll
    for (int j = 0; j < 4; ++j) {
      float ss = 0.f;
#pragma unroll
      for (int nt = 0; nt < 4; ++nt) ss += hacc[nt][j] * hacc[nt][j];
      ss = g16_sum(ss);
      const float rstd = rsqrtf(ss * (1.f / 64.f) + EPS);
      const size_t row = row0 + w * 16 + q * 4 + j;
#pragma unroll
      for (int nt = 0; nt < 4; ++nt) {
        const int e = nt * 16 + r;
        const float om = bf2f(P[row * NP + PC_OM + h * 64 + e]);
        const float sg = 1.f / (1.f + __expf(-om));
        mix[row * 1024 + 512 + h * 64 + e] = f2bf(sg * hacc[nt][j] * rstd * p.mlstm_norm_g[l * 256 + h * 64 + e]);
      }
    }
  }
}

DI void g16_max4(float& a, float& b, float& c, float& d) {
  asm volatile(
      "s_nop 1\n\t"
      "v_max_f32_dpp %0, %0, %0 row_ror:8 row_mask:0xf bank_mask:0xf\n\t"
      "v_max_f32_dpp %1, %1, %1 row_ror:8 row_mask:0xf bank_mask:0xf\n\t"
      "v_max_f32_dpp %2, %2, %2 row_ror:8 row_mask:0xf bank_mask:0xf\n\t"
      "v_max_f32_dpp %3, %3, %3 row_ror:8 row_mask:0xf bank_mask:0xf\n\t"
      "v_max_f32_dpp %0, %0, %0 row_ror:4 row_mask:0xf bank_mask:0xf\n\t"
      "v_max_f32_dpp %1, %1, %1 row_ror:4 row_mask:0xf bank_mask:0xf\n\t"
      "v_max_f32_dpp %2, %2, %2 row_ror:4 row_mask:0xf bank_mask:0xf\n\t"
      "v_max_f32_dpp %3, %3, %3 row_ror:4 row_mask:0xf bank_mask:0xf\n\t"
      "v_max_f32_dpp %0, %0, %0 row_ror:2 row_mask:0xf bank_mask:0xf\n\t"
      "v_max_f32_dpp %1, %1, %1 row_ror:2 row_mask:0xf bank_mask:0xf\n\t"
      "v_max_f32_dpp %2, %2, %2 row_ror:2 row_mask:0xf bank_mask:0xf\n\t"
      "v_max_f32_dpp %3, %3, %3 row_ror:2 row_mask:0xf bank_mask:0xf\n\t"
      "v_max_f32_dpp %0, %0, %0 row_ror:1 row_mask:0xf bank_mask:0xf\n\t"
      "v_max_f32_dpp %1, %1, %1 row_ror:1 row_mask:0xf bank_mask:0xf\n\t"
      "v_max_f32_dpp %2, %2, %2 row_ror:1 row_mask:0xf bank_mask:0xf\n\t"
      "v_max_f32_dpp %3, %3, %3 row_ror:1 row_mask:0xf bank_mask:0xf"
      : "+v"(a), "+v"(b), "+v"(c), "+v"(d));
}

constexpr unsigned CT0 = 0xE0331000u, CT1 = 0xF0401101u, CT2 = 0xFF411202u, CT3 = 0xFF421303u, CT4 = 0xFF501404u, CT5 = 0xFF511505u, CT6 = 0xFF601606u, CT7 = 0xFF611707u, CT8 = 0xFF702008u, CT9 = 0xFF712109u, CT10 = 0xFF80220Au, CT11 = 0xFF90230Bu, CT12 = 0xFFA0240Cu, CT13 = 0xFFB0300Du, CT14 = 0xFFC0310Eu, CT15 = 0xFFD0320Fu;
struct TopE { float s; int i; };

DI void phase_scores(const Params& p, int l, char* smem) {
  bf16_t* sA = (bf16_t*)smem;
  bf16_t* sB = sA + 64 * LDT;
  TopE* sTop = (TopE*)(sB + 128 * LDT);
  const int tid = otid(), lane = tid & 63, w = tid >> 6, r = lane & 15, q = lane >> 4;
  const bf16_t* QP = (const bf16_t*)(p.ws + OFF_QP);
  const bf16_t* KB = (const bf16_t*)(p.ws + OFF_KEYS);
  int* EIDX = (int*)(p.ws + OFF_EIDX);
  float* EG = (float*)(p.ws + OFF_EGATE);
  u32x4 pa[2], pb[4];
  const int prow = tid >> 2, pd = (tid & 3) * 16;
#define SC_LOAD(ITEM, C, KH) { \
    const bf16_t* qsrc_ = QP + (size_t)(((ITEM) >> 3) * 64 + prow) * 2048 + ((ITEM) & 7) * 256 + (C) * 128 + (KH) * 64 + pd; \
    const bf16_t* ksrc_ = KB + ((size_t)((l * 8 + ((ITEM) & 7)) * 2 + (C)) * 128 + prow) * 128 + (KH) * 64 + pd; \
    pa[0] = *(const u32x4*)(qsrc_); pa[1] = *(const u32x4*)(qsrc_ + 8); \
    pb[0] = *(const u32x4*)(ksrc_); pb[1] = *(const u32x4*)(ksrc_ + 8); \
    pb[2] = *(const u32x4*)(ksrc_ + 64 * 128); pb[3] = *(const u32x4*)(ksrc_ + 64 * 128 + 8); }
  if ((int)blockIdx.x < 1024) SC_LOAD((int)blockIdx.x, 0, 0)
  for (int item = blockIdx.x; item < 1024; item += gridDim.x) {
    const int tt = item >> 3, hh = item & 7;
    const int row0 = tt * 64;
#pragma unroll 1
    for (int c = 0; c < 2; ++c) {
      f32x4 acc[8];
#pragma unroll
      for (int nt = 0; nt < 8; ++nt) acc[nt] = (f32x4){0.f, 0.f, 0.f, 0.f};
#pragma unroll 1
      for (int kh = 0; kh < 2; ++kh) {
        __syncthreads();
        *(u32x4*)(sA + prow * LDT + pd) = pa[0]; *(u32x4*)(sA + prow * LDT + pd + 8) = pa[1];
        *(u32x4*)(sB + prow * LDT + pd) = pb[0]; *(u32x4*)(sB + prow * LDT + pd + 8) = pb[1];
        *(u32x4*)(sB + (64 + prow) * LDT + pd) = pb[2]; *(u32x4*)(sB + (64 + prow) * LDT + pd + 8) = pb[3];
        __syncthreads();
        {
          const int st = c * 2 + kh;
          if (st < 3) { const int cn = (st + 1) >> 1, kn = (st + 1) & 1; SC_LOAD(item, cn, kn) }
          else if (item + (int)gridDim.x < 1024) { SC_LOAD(item + (int)gridDim.x, 0, 0) }
        }
        mma_lds<8, 2>(sA + w * 16 * LDT, sB, acc, lane);
      }
      {
        float v[4][8];
#pragma unroll
        for (int j = 0; j < 4; ++j)
#pragma unroll
          for (int nt = 0; nt < 8; ++nt)
            v[j][nt] = __uint_as_float((__float_as_uint(acc[nt][j]) & ~0x7Fu) | (unsigned)(127 - (nt * 16 + r)));
#define CE_(j, x, y) { const float hi_ = fmaxf(v[j][x], v[j][y]), lo_ = fminf(v[j][x], v[j][y]); v[j][x] = hi_; v[j][y] = lo_; }
#pragma unroll
        for (int j = 0; j < 4; ++j) {
          CE_(j, 0, 1) CE_(j, 2, 3) CE_(j, 4, 5) CE_(j, 6, 7)
          CE_(j, 0, 2) CE_(j, 1, 3) CE_(j, 4, 6) CE_(j, 5, 7)
          CE_(j, 1, 2) CE_(j, 5, 6) CE_(j, 0, 4) CE_(j, 3, 7)
          CE_(j, 1, 5) CE_(j, 2, 6)
          CE_(j, 1, 4) CE_(j, 3, 6)
          CE_(j, 2, 4) CE_(j, 3, 5)
          CE_(j, 3, 4)
        }
#undef CE_
        float myK[4] = {0.f, 0.f, 0.f, 0.f};
#pragma unroll 2
        for (int itk = 0; itk < 16; ++itk) {
          const bool rec = (r == itk);
          float gmx[4] = {v[0][0], v[1][0], v[2][0], v[3][0]};
          g16_max4(gmx[0], gmx[1], gmx[2], gmx[3]);
#pragma unroll
          for (int j = 0; j < 4; ++j) {
            const float gm = gmx[j];
            const bool win = (v[j][0] == gm);
#pragma unroll
            for (int s2 = 0; s2 < 7; ++s2) v[j][s2] = win ? v[j][s2 + 1] : v[j][s2];
            v[j][7] = win ? -INFINITY : v[j][7];
            myK[j] = rec ? gm : myK[j];
          }
        }
#pragma unroll
        for (int j = 0; j < 4; ++j) {
          TopE te; te.s = __uint_as_float(__float_as_uint(myK[j]) & ~0x7Fu); te.i = 127 - (int)(__float_as_uint(myK[j]) & 0x7Fu);
          sTop[((w * 16 + q * 4 + j) * 2 + c) * 16 + r] = te;
        }
      }
    }
    __syncthreads();
    const unsigned ctab = (r == 0) ? CT0 : (r == 1) ? CT1 : (r == 2) ? CT2 : (r == 3) ? CT3 : (r == 4) ? CT4 : (r == 5) ? CT5 : (r == 6) ? CT6 : (r == 7) ? CT7 :
                          (r == 8) ? CT8 : (r == 9) ? CT9 : (r == 10) ? CT10 : (r == 11) ? CT11 : (r == 12) ? CT12 : (r == 13) ? CT13 : (r == 14) ? CT14 : CT15;
    {
      float cv[4][4];
#pragma unroll
      for (int j = 0; j < 4; ++j) {
        const int rl = w * 16 + q * 4 + j;
#pragma unroll
        for (int sl = 0; sl < 4; ++sl) {
          const unsigned code = (ctab >> (8 * sl)) & 0xFFu;
          const bool valid = code != 0xFFu;
          const unsigned cc = valid ? code : 0u;
          const float sum = sTop[(rl * 2 + 0) * 16 + (cc >> 4)].s + sTop[(rl * 2 + 1) * 16 + (cc & 15u)].s;
          cv[j][sl] = valid ? __uint_as_float((__float_as_uint(sum) & ~0xFFu) | (255u - code)) : -INFINITY;
        }
#define CE2_(x, y) { const float hi_ = fmaxf(cv[j][x], cv[j][y]), lo_ = fminf(cv[j][x], cv[j][y]); cv[j][x] = hi_; cv[j][y] = lo_; }
        CE2_(0, 1) CE2_(2, 3) CE2_(0, 2) CE2_(1, 3) CE2_(1, 2)
#undef CE2_
      }
      float myK[4] = {0.f, 0.f, 0.f, 0.f};
#pragma unroll 2
      for (int itk = 0; itk < 16; ++itk) {
        const bool rec = (r == itk);
        float gmx[4] = {cv[0][0], cv[1][0], cv[2][0], cv[3][0]};
        g16_max4(gmx[0], gmx[1], gmx[2], gmx[3]);
#pragma unroll
        for (int j = 0; j < 4; ++j) {
          const bool win = (cv[j][0] == gmx[j]);
          cv[j][0] = win ? cv[j][1] : cv[j][0];
          cv[j][1] = win ? cv[j][2] : cv[j][1];
          cv[j][2] = win ? cv[j][3] : cv[j][2];
          cv[j][3] = win ? -INFINITY : cv[j][3];
          myK[j] = rec ? gmx[j] : myK[j];
        }
      }
#pragma unroll
      for (int j = 0; j < 4; ++j) {
        const int rl = w * 16 + q * 4 + j;
        const int pidx = 255 - (int)(__float_as_uint(myK[j]) & 0xFFu);
        const TopE e0 = sTop[(rl * 2 + 0) * 16 + (pidx >> 4)];
        const TopE e1 = sTop[(rl * 2 + 1) * 16 + (pidx & 15)];
        const float myS = e0.s + e1.s;
        const float mx = g16_max(myS);
        const float ex = __expf(myS - mx);
        const float sm = g16_sum(ex);
        const size_t o = (size_t)(row0 + rl) * 128 + hh * 16 + r;
        EIDX[o] = e0.i * 128 + e1.i;
        EG[o] = ex / sm;
      }
    }
  }
}

#undef SC_LOAD
DI void phase_experts(const Params& p, int l, char* smem) {
  const int tid = otid(), lane = tid & 63, w = tid >> 6, sub = lane & 15, gq = lane >> 4;
  float* sWt = (float*)smem + w * 384;
  int* sIdx = (int*)(sWt + 128);
  float* sG = sWt + 256;
  const bf16_t* H = (const bf16_t*)(p.ws + OFF_H);
  const unsigned char* U = (const unsigned char*)(p.ws + OFF_U16) + (size_t)l * 16384 * 1024;
  const unsigned char* V = (const unsigned char*)(p.ws + OFF_V16) + (size_t)l * 16384 * 1024;
  const int* EIDX = (const int*)(p.ws + OFF_EIDX);
  const float* EG = (const float*)(p.ws + OFF_EGATE);
  float* X = (float*)(p.ws + OFF_X);
  const float* mod = (const float*)(p.ws + OFF_MOD);
  for (int tok = blockIdx.x * 4 + w; tok < T; tok += gridDim.x * 4) {
    sIdx[lane] = EIDX[(size_t)tok * 128 + lane]; sIdx[lane + 64] = EIDX[(size_t)tok * 128 + 64 + lane];
    sG[lane] = EG[(size_t)tok * 128 + lane]; sG[lane + 64] = EG[(size_t)tok * 128 + 64 + lane];
    unsigned hvs[32];
#pragma unroll
    for (int i = 0; i < 4; ++i) {
      const uint4 t0 = *(const uint4*)(H + (size_t)tok * 1024 + i * 256 + sub * 16);
      const uint4 t1 = *(const uint4*)(H + (size_t)tok * 1024 + i * 256 + sub * 16 + 8);
      hvs[i * 8 + 0] = t0.x; hvs[i * 8 + 1] = t0.y; hvs[i * 8 + 2] = t0.z; hvs[i * 8 + 3] = t0.w;
      hvs[i * 8 + 4] = t1.x; hvs[i * 8 + 5] = t1.y; hvs[i * 8 + 6] = t1.z; hvs[i * 8 + 7] = t1.w;
    }
#pragma unroll 4
    for (int it = 0; it < 32; ++it) {
      const int k = it * 4 + gq;
      const unsigned char* ur = U + (size_t)sIdx[k] * 1024 + sub * 16;
      unsigned uvs[16];
#pragma unroll
      for (int i = 0; i < 4; ++i) {
        const uint4 t = *(const uint4*)(ur + 256 * i);
        uvs[i * 4 + 0] = t.x; uvs[i * 4 + 1] = t.y; uvs[i * 4 + 2] = t.z; uvs[i * 4 + 3] = t.w;
      }
      float acc = 0.f;
#pragma unroll
      for (int i = 0; i < 16; ++i) {
        const bf16x2_t lo = __builtin_amdgcn_cvt_scalef32_pk_bf16_fp8((int)uvs[i], 1.0f, false);
        const bf16x2_t hi = __builtin_amdgcn_cvt_scalef32_pk_bf16_fp8((int)uvs[i], 1.0f, true);
        acc = __builtin_amdgcn_fdot2_f32_bf16(lo, __builtin_bit_cast(bf16x2_t, hvs[i * 2]), acc, false);
        acc = __builtin_amdgcn_fdot2_f32_bf16(hi, __builtin_bit_cast(bf16x2_t, hvs[i * 2 + 1]), acc, false);
      }
      acc = g16_sum(acc) * (1.f / 256.f);
      const float ge = 0.5f * acc * (1.f + erff(acc * 0.70710678118654752f));
      if (sub == 0) sWt[k] = ge * sG[k] * (1.f / 64.f);
    }
    float o[16];
#pragma unroll
    for (int i = 0; i < 16; ++i) o[i] = 0.f;
#pragma unroll 16
    for (int k = 0; k < 128; ++k) {
      const uint4 t = *(const uint4*)(V + (size_t)sIdx[k] * 1024 + lane * 16);
      const float wk = sWt[k];
      const unsigned tw[4] = {t.x, t.y, t.z, t.w};
#pragma unroll
      for (int d = 0; d < 4; ++d) {
        const f32x2 lo = __builtin_amdgcn_cvt_pk_f32_fp8((int)tw[d], false);
        const f32x2 hi = __builtin_amdgcn_cvt_pk_f32_fp8((int)tw[d], true);
        o[d * 4 + 0] += wk * lo.x; o[d * 4 + 1] += wk * lo.y; o[d * 4 + 2] += wk * hi.x; o[d * 4 + 3] += wk * hi.y;
      }
    }
    const int ci = tok_ci(tok);
    float xv[16], g2[16];
    load_row16(X + (size_t)tok * 1024, lane, xv);
    load_row16(mod + (size_t)(l * 3 + ci) * 6144 + 5120, lane, g2);
#pragma unroll
    for (int i = 0; i < 16; ++i) xv[i] += g2[i] * o[i];
    if (l == 0) {
      store_row16(X + (size_t)tok * 1024, lane, xv);
      const float* md = mod + (size_t)(3 + ci) * 6144;
      norm_mod_emit(xv, lane, p.norm1_g + 1024, md + 1024, md, (bf16_t*)(p.ws + OFF_H) + (size_t)tok * 1024,
                    (const float*)(p.ws + OFF_WGT) + (size_t)16 * 1024, (float*)(p.ws + OFF_GATES) + (size_t)tok * 16);
    } else {
      float ss = 0.f;
#pragma unroll
      for (int i = 0; i < 16; ++i) ss += xv[i] * xv[i];
      ss = wave_sum(ss);
      const float rstd = rsqrtf(ss * (1.f / 1024.f) + EPS);
      float gv[16];
      load_row16(p.final_norm_g, lane, gv);
#pragma unroll
      for (int i = 0; i < 16; ++i) xv[i] = xv[i] * rstd * gv[i];
      store_row16(p.out + (size_t)tok * 1024, lane, xv);
    }
  }
}


#define XB_TMO      128
#define XB_XCNT(j)  (256  + 64 * (j))
#define XB_XSUB(j)  (1280 + 64 * (j))
#define XB_XGEN(j)  (2304 + 64 * (j))
#define XB_TOP      3328
#define XB_TOPGEN   3392
#define XCD_BAR_WORDS 3456
#define XB_SPIN_CAP (1u << 18)
#define LAS __attribute__((address_space(3)))

__device__ __forceinline__ unsigned xb_ld(unsigned* p)              { return __hip_atomic_load(p, __ATOMIC_RELAXED, __HIP_MEMORY_SCOPE_AGENT); }
__device__ __forceinline__ unsigned xb_add(unsigned* p, unsigned v) { return __hip_atomic_fetch_add(p, v, __ATOMIC_RELAXED, __HIP_MEMORY_SCOPE_AGENT); }
__device__ __forceinline__ unsigned xb_xcc_id() { return (unsigned)__builtin_amdgcn_s_getreg((3 << 11) | 20) & 0xFu; }
#define XB_SPIN(cond, bar) do { unsigned _sp = 0; while (cond) { __builtin_amdgcn_s_sleep(1); \
    if ((++_sp & 255u) == 0u) { if (xb_ld(&(bar)[XB_TMO])) break; if (_sp > XB_SPIN_CAP) { atomicAdd(&(bar)[XB_TMO], 1u); break; } } } } while (0)

struct XcdBarrier {
    unsigned* bar; unsigned x;
    volatile LAS unsigned* st;
};

__device__ __forceinline__ XcdBarrier xcd_barrier_post(unsigned* bar, volatile LAS unsigned* st) {
    XcdBarrier b; b.bar = bar; b.x = xb_xcc_id(); b.st = st;
    if (threadIdx.x == 0) (void)xb_add(&bar[XB_XCNT(b.x)], 1u);
    return b;
}
__device__ __forceinline__ void xcd_barrier_complete(unsigned* bar, unsigned x, unsigned& nloc, unsigned& nx) {
    const unsigned G = gridDim.x * gridDim.y * gridDim.z;
    unsigned sum, cnt, mine, sp = 0u;
    for (;;) {
        sum = 0u; cnt = 0u; mine = 0u;
#pragma unroll
        for (unsigned j = 0; j < 16; ++j) { const unsigned c = xb_ld(&bar[XB_XCNT(j)]); sum += c; cnt += (c > 0u) ? 1u : 0u; mine = (j == x) ? c : mine; }
        if (sum == G) break;
        __builtin_amdgcn_s_sleep(1);
        if ((++sp & 255u) == 0u) { if (xb_ld(&bar[XB_TMO])) break; if (sp > XB_SPIN_CAP) { atomicAdd(&bar[XB_TMO], 1u); break; } }
    }
    nloc = mine > 0u ? mine : 1u; nx = cnt > 0u ? cnt : 1u;
}

__device__ __forceinline__ void xcd_barrier(const XcdBarrier& b) {
    asm volatile("s_waitcnt vmcnt(0)" ::: "memory");
    __syncthreads();
    if (threadIdx.x == 0) {
        unsigned* bar = b.bar;
        __builtin_amdgcn_s_waitcnt(0);
        unsigned nloc = b.st[0], nx = b.st[1];
        if (nloc == 0u) { xcd_barrier_complete(bar, b.x, nloc, nx); b.st[0] = nloc; b.st[1] = nx; }
        const unsigned old = xb_add(&bar[XB_XSUB(b.x)], 1u);
        const unsigned gen = old / nloc;
        if (old + 1u == (gen + 1u) * nloc) {
            __builtin_amdgcn_fence(__ATOMIC_RELEASE, "agent");
            asm volatile("s_waitcnt vmcnt(0)" ::: "memory");
            const unsigned og = xb_add(&bar[XB_TOP], 1u);
            const unsigned tg = og / nx;
            if (og + 1u == (tg + 1u) * nx) xb_add(&bar[XB_TOPGEN], 1u);
            else XB_SPIN(xb_ld(&bar[XB_TOPGEN]) == tg, bar);
            __builtin_amdgcn_fence(__ATOMIC_ACQUIRE, "agent");
            xb_add(&bar[XB_XGEN(b.x)], 1u);
            asm volatile("s_waitcnt vmcnt(0)" ::: "memory");
        } else {
            XB_SPIN(xb_ld(&bar[XB_XGEN(b.x)]) == gen, bar);
            __builtin_amdgcn_fence(__ATOMIC_ACQUIRE, "agent");
            asm volatile("s_waitcnt vmcnt(0)" ::: "memory");
        }
    }
    __syncthreads();
}


template <int CTRL> DI float dpp_mov(float v) {
  return __builtin_bit_cast(float, __builtin_amdgcn_update_dpp(0, __builtin_bit_cast(int, v), CTRL, 0xF, 0xF, false));
}
DI float g8_sum(float v) { v += dpp_mov<0xB1>(v); v += dpp_mov<0x4E>(v); v += dpp_mov<0x141>(v); return v; }

DI void team_info(const Params& p, const int* s_team, int& rank, int& nloc, int& pi, int& np) {
  unsigned* bar = (unsigned*)(p.ws + OFF_BAR);
  const unsigned x = xb_xcc_id();
  int np_ = 0, pi_ = 0, nl = 1;
#pragma unroll
  for (unsigned j = 0; j < 16; ++j) {
    const unsigned c = xb_ld(&bar[XB_XCNT(j)]);
    if (c > 0u) { np_ += 1; if (j < x) pi_ += 1; }
    if (j == x) nl = (int)c;
  }
  rank = s_team[0]; nloc = nl > 0 ? nl : 1; pi = pi_; np = np_ > 0 ? np_ : 1;
}

DI void phase_expA(const Params& p, int l, char* smem, const int* s_team) {
  const int tid = otid(), lane = tid & 63, w = __builtin_amdgcn_readfirstlane(tid >> 6), j8 = lane & 7, g = lane >> 3;
  int rank, nloc, pi, np;
  team_info(p, s_team, rank, nloc, pi, np);
  int* sIdx = (int*)smem + w * 128;
  const bf16_t* H = (const bf16_t*)(p.ws + OFF_H);
  const int* EIDX = (const int*)(p.ws + OFF_EIDX);
  float* PART = (float*)(p.ws + OFF_QP);
  const int stride = nloc * 4;
  for (int s = pi; s < 8; s += np) {
    const unsigned char* Us = (const unsigned char*)(p.ws + OFF_U16) + (((size_t)(l * 8 + s) * 16384) << 7);
    int tok = rank * 4 + w;
    int e0n = 0, e1n = 0;
    uint4 h0n = make_uint4(0, 0, 0, 0), h1n = h0n;
    if (tok < T) {
      e0n = EIDX[(size_t)tok * 128 + lane]; e1n = EIDX[(size_t)tok * 128 + 64 + lane];
      h0n = *(const uint4*)(H + (size_t)tok * 1024 + s * 128 + j8 * 16);
      h1n = *(const uint4*)(H + (size_t)tok * 1024 + s * 128 + j8 * 16 + 8);
    }
    for (; tok < T; tok += stride) {
      sIdx[lane] = e0n; sIdx[lane + 64] = e1n;
      const unsigned hv[8] = {h0n.x, h0n.y, h0n.z, h0n.w, h1n.x, h1n.y, h1n.z, h1n.w};
      uint4 tq[16];
#pragma unroll
      for (int it = 0; it < 16; ++it) tq[it] = *(const uint4*)(Us + (((unsigned)sIdx[it * 8 + g] << 7) + (unsigned)(j8 * 16)));
      const int nt = tok + stride;
      if (nt < T) {
        e0n = EIDX[(size_t)nt * 128 + lane]; e1n = EIDX[(size_t)nt * 128 + 64 + lane];
        h0n = *(const uint4*)(H + (size_t)nt * 1024 + s * 128 + j8 * 16);
        h1n = *(const uint4*)(H + (size_t)nt * 1024 + s * 128 + j8 * 16 + 8);
      }
      float my0 = 0.f, my1 = 0.f;
#pragma unroll
      for (int it = 0; it < 16; ++it) {
        const unsigned tw[4] = {tq[it].x, tq[it].y, tq[it].z, tq[it].w};
        float acc = 0.f;
#pragma unroll
        for (int d = 0; d < 4; ++d) {
          const bf16x2_t lo = __builtin_amdgcn_cvt_scalef32_pk_bf16_fp8((int)tw[d], 1.0f, false);
          const bf16x2_t hi = __builtin_amdgcn_cvt_scalef32_pk_bf16_fp8((int)tw[d], 1.0f, true);
          acc = __builtin_amdgcn_fdot2_f32_bf16(lo, __builtin_bit_cast(bf16x2_t, hv[d * 2]), acc, false);
          acc = __builtin_amdgcn_fdot2_f32_bf16(hi, __builtin_bit_cast(bf16x2_t, hv[d * 2 + 1]), acc, false);
        }
        acc = g8_sum(acc);
        if ((it & 7) == j8) { if (it < 8) my0 = acc; else my1 = acc; }
      }
      float* pr = PART + ((size_t)s * T + tok) * 128;
      pr[j8 * 8 + g] = my0;
      pr[(j8 + 8) * 8 + g] = my1;
    }
  }
}

DI void phase_expW(const Params& p) {
  const int tid = otid(), lane = tid & 63;
  const int gw = blockIdx.x * 4 + __builtin_amdgcn_readfirstlane(tid >> 6), nw = gridDim.x * 4;
  float* EG = (float*)(p.ws + OFF_EGATE);
  const float* PART = (const float*)(p.ws + OFF_QP);
  for (int tok = gw; tok < T; tok += nw) {
#pragma unroll
    for (int kk = 0; kk < 2; ++kk) {
      const int k = lane + 64 * kk;
      float pv[8];
#pragma unroll
      for (int s2 = 0; s2 < 8; ++s2) pv[s2] = PART[((size_t)s2 * T + tok) * 128 + k];
      float a = ((pv[0] + pv[1]) + (pv[2] + pv[3])) + ((pv[4] + pv[5]) + (pv[6] + pv[7]));
      a *= (1.f / 256.f);
      const float ge = 0.5f * a * (1.f + erff(a * 0.70710678118654752f));
      EG[(size_t)tok * 128 + k] = ge * EG[(size_t)tok * 128 + k] * (1.f / 64.f);
    }
  }
}

DI void phase_expB(const Params& p, int l, char* smem, const int* s_team) {
  const int tid = otid(), lane = tid & 63, w = __builtin_amdgcn_readfirstlane(tid >> 6), j8 = lane & 7, g = lane >> 3;
  int rank, nloc, pi, np;
  team_info(p, s_team, rank, nloc, pi, np);
  float* sW = (float*)smem + w * 256;
  int* sIdx = (int*)(sW + 128);
  const int* EIDX = (const int*)(p.ws + OFF_EIDX);
  const float* EW = (const float*)(p.ws + OFF_EGATE);
  float* X = (float*)(p.ws + OFF_X);
  const float* mod = (const float*)(p.ws + OFF_MOD);
  const int stride = nloc * 4;
  const int dsub = j8 * 16 + ((lane & 32) ? 8 : 0) + ((lane & 16) ? 4 : 0) + ((lane & 8) ? 2 : 0);
  for (int s = pi; s < 8; s += np) {
    const unsigned char* Vs = (const unsigned char*)(p.ws + OFF_V16) + (((size_t)(l * 8 + s) * 16384) << 7);
    int tok = rank * 4 + w;
    float wn0 = 0.f, wn1 = 0.f;
    int en0 = 0, en1 = 0;
    if (tok < T) {
      wn0 = EW[(size_t)tok * 128 + lane]; wn1 = EW[(size_t)tok * 128 + 64 + lane];
      en0 = EIDX[(size_t)tok * 128 + lane]; en1 = EIDX[(size_t)tok * 128 + 64 + lane];
    }
    for (; tok < T; tok += stride) {
      sW[lane] = wn0; sW[lane + 64] = wn1; sIdx[lane] = en0; sIdx[lane + 64] = en1;
      uint4 tq[16];
#pragma unroll
      for (int it = 0; it < 16; ++it) tq[it] = *(const uint4*)(Vs + (((unsigned)sIdx[it * 8 + g] << 7) + (unsigned)(j8 * 16)));
      const int dim = s * 128 + dsub;
      const float2 g2 = *(const float2*)(mod + (size_t)(l * 3 + tok_ci(tok)) * 6144 + 5120 + dim);
      float2* xp = (float2*)(X + (size_t)tok * 1024 + dim);
      float2 xv = *xp;
      const int nt = tok + stride;
      if (nt < T) {
        wn0 = EW[(size_t)nt * 128 + lane]; wn1 = EW[(size_t)nt * 128 + 64 + lane];
        en0 = EIDX[(size_t)nt * 128 + lane]; en1 = EIDX[(size_t)nt * 128 + 64 + lane];
      }
      f32x2 o2[8];
#pragma unroll
      for (int i = 0; i < 8; ++i) o2[i] = (f32x2){0.f, 0.f};
#pragma unroll
      for (int it = 0; it < 16; ++it) {
        const float wk = sW[it * 8 + g];
        const f32x2 wk2 = (f32x2){wk, wk};
        const unsigned tw[4] = {tq[it].x, tq[it].y, tq[it].z, tq[it].w};
#pragma unroll
        for (int d = 0; d < 4; ++d) {
          const f32x2 lo = __builtin_amdgcn_cvt_pk_f32_fp8((int)tw[d], false);
          const f32x2 hi = __builtin_amdgcn_cvt_pk_f32_fp8((int)tw[d], true);
          o2[d * 2] = lo * wk2 + o2[d * 2];
          o2[d * 2 + 1] = hi * wk2 + o2[d * 2 + 1];
        }
      }
      float o[16];
#pragma unroll
      for (int i = 0; i < 8; ++i) { o[2 * i] = o2[i].x; o[2 * i + 1] = o2[i].y; }
      typedef unsigned u32x2_ __attribute__((ext_vector_type(2)));
#pragma unroll
      for (int j = 0; j < 8; ++j) {
        const u32x2_ sw = __builtin_amdgcn_permlane32_swap(__float_as_uint(o[j]), __float_as_uint(o[j + 8]), false, false);
        o[j] = __uint_as_float(sw.x) + __uint_as_float(sw.y);
      }
#pragma unroll
      for (int j = 0; j < 4; ++j) {
        const u32x2_ sw = __builtin_amdgcn_permlane16_swap(__float_as_uint(o[j]), __float_as_uint(o[j + 4]), false, false);
        o[j] = __uint_as_float(sw.x) + __uint_as_float(sw.y);
      }
      {
        const bool up = lane & 8;
#pragma unroll
        for (int j = 0; j < 2; ++j) { const float send = up ? o[j] : o[j + 2], keep = up ? o[j + 2] : o[j]; o[j] = keep + dpp_ror<8>(send); }
      }
      xv.x += g2.x * o[0]; xv.y += g2.y * o[1];
      *xp = xv;
    }
  }
}

#define PH(k, call) if (p.phase_lo <= (k) && (k) <= p.phase_hi) { if ((k) > p.phase_lo) { if (p.phase_hi == 0x7fffffff) cg::this_grid().sync(); xcd_barrier(xb); } call; }
#define LAYER(l, base) \
  PH(base + 1, (phase_gemm<0>(p, l, (const bf16_t*)(p.ws + OFF_H), (const bf16_t*)(p.ws + OFF_WINT) + (size_t)l * 2048 * 1024, 2048, smem), deferred_convert(p, l, 256, 6, false, smem))) \
  PH(base + 2, phase_mixers(p, l, smem)) \
  PH(base + 4, (phase_mlstm_out(p, l, smem), deferred_convert(p, l, 512, 8, false, smem))) \
  PH(base + 5, (phase_gemm<1>(p, l, (const bf16_t*)(p.ws + OFF_MIX), (const bf16_t*)(p.ws + OFF_WOUTT) + (size_t)l * 1024 * 1024, 1024, smem), deferred_convert(p, l, 512, 10, false, smem))) \
  PH(base + 6, phase_norm(p, l, 1)) \
  PH(base + 7, (phase_gemm<2>(p, l, (const bf16_t*)(p.ws + OFF_H), (const bf16_t*)(p.ws + OFF_WQT) + (size_t)l * 2048 * 1024, 2048, smem), deferred_convert(p, l, 256, 6, false, smem))) \
  PH(base + 8, (phase_scores(p, l, smem), deferred_convert(p, l, 256, 12, false, smem), deferred_convert(p, l, 0, 4, true, smem))) \
  PH(base + 9, phase_expA(p, l, smem, s_team)) \
  PH(base + 10, phase_expW(p)) \
  PH(base + 11, phase_expB(p, l, smem, s_team)) \
  PH(base + 12, phase_norm(p, l + 1, l == 0 ? 2 : 3))

constexpr int N_PHASES = 26;
__global__ void __launch_bounds__(256, 3) fwd_megakernel(Params p) {
  __shared__ __attribute__((aligned(16))) char smem[SMEM_BYTES];
  __shared__ uint4 xb_words;
  __shared__ int s_team[4];
  if (threadIdx.x == 0) {
    xb_words = make_uint4(0u, 0u, 0u, 0u);
    s_team[0] = (int)atomicAdd((unsigned*)(p.ws + OFF_BAR) + 3584 + xb_xcc_id() * 32, 1u);
  }
  __syncthreads();
  XcdBarrier xb = xcd_barrier_post((unsigned*)(p.ws + OFF_BAR), (volatile LAS unsigned*)&xb_words);
  PH(0, phase_prologue(p, smem))
  PH(1, phase_norm(p, 0, 0))
  LAYER(0, 1)
  LAYER(1, 13)
}

extern "C" void kernel_launch(void* const* d_in, const int* in_sizes, int n_in, void* d_out, int out_size, void* d_ws, size_t ws_size,
                              hipStream_t stream) {
  Params p{};
  const float** f = (const float**)&p;
  for (int i = 0; i < 25; ++i) f[i] = (const float*)d_in[i];
  p.out = (float*)d_out;
  p.ws = (char*)d_ws;
  static int grid_blocks = 0;
  if (!grid_blocks) {
    int dev = 0, cus = 0, per_cu = 0;
    hipGetDevice(&dev);
    hipDeviceGetAttribute(&cus, hipDeviceAttributeMultiprocessorCount, dev);
    hipOccupancyMaxActiveBlocksPerMultiprocessor(&per_cu, fwd_megakernel, 256, 0);
    if (per_cu > 3) per_cu = 3;
    if (per_cu < 1) per_cu = 1;
    grid_blocks = cus * per_cu;
  }
#if MULTI_LAUNCH
  for (int ph = 0; ph < N_PHASES; ++ph) {
    p.phase_lo = ph; p.phase_hi = ph;
    hipLaunchKernelGGL(fwd_megakernel, dim3(grid_blocks), dim3(256), 0, stream, p);
  }
#else
  p.phase_lo = 0; p.phase_hi = N_PHASES - 1;
  hipMemsetAsync((char*)d_ws + OFF_BAR, 0, 32768, stream);
  void* args[] = {&p};
  hipError_t e = hipLaunchCooperativeKernel((void*)fwd_megakernel, dim3(grid_blocks), dim3(256), args, 0, stream);
  if (e != hipSuccess) fprintf(stderr, "cooperative launch failed: %s (grid %d)\n", hipGetErrorString(e), grid_blocks);
#endif
}
```

```cpp
#include <hip/hip_runtime.h>
#include <hip/hip_cooperative_groups.h>
#include <cstdio>
#include <cstdint>
namespace cg = cooperative_groups;

#ifndef MULTI_LAUNCH
#define MULTI_LAUNCH 0
#endif

typedef unsigned short bf16_t;
using bf16x8 = __attribute__((ext_vector_type(8))) short;
using f32x4 = __attribute__((ext_vector_type(4))) float;
using u32x4 = __attribute__((ext_vector_type(4))) unsigned;
typedef __bf16 bf16x2_t __attribute__((ext_vector_type(2)));
typedef float f32x2 __attribute__((ext_vector_type(2)));
#define DI __device__ __forceinline__

constexpr int T = 8192, TC = 4096;
constexpr int NP = 2048;
constexpr int PC_QA = 0, PC_KA = 512, PC_VA = 640, PC_QM = 768, PC_KM = 1024, PC_VM = 1280, PC_OM = 1536, PC_XP = 1792;
constexpr int LDT = 72;
constexpr float EPS = 1e-6f;

constexpr size_t OUT_YP = 0, OUT_YS = 4194304, OUT_CK = 8388608, OUT_CV = 9437184, OUT_SC = 10485760, OUT_SN = 11534336, OUT_SM = 11550720;

constexpr size_t OFF_WINT = 0;
constexpr size_t OFF_WOUTT = OFF_WINT + 8388608;
constexpr size_t OFF_WQT = OFF_WOUTT + 4194304;
constexpr size_t OFF_KEYS = OFF_WQT + 8388608;
constexpr size_t OFF_WGT = OFF_KEYS + 1048576;
constexpr size_t OFF_MOD = OFF_WGT + 131072;
constexpr size_t OFF_ROPE = OFF_MOD + 147456;
constexpr size_t OFF_X = OFF_ROPE + 8192;
constexpr size_t OFF_H = OFF_X + 33554432;
constexpr size_t OFF_P = OFF_H + 16777216;
constexpr size_t OFF_GATES = OFF_P + 33554432;
constexpr size_t OFF_MIX = OFF_GATES + 524288;
constexpr size_t OFF_QP = OFF_MIX + 16777216;
constexpr size_t OFF_EIDX = OFF_QP + 33554432;
constexpr size_t OFF_EGATE = OFF_EIDX + 4194304;
constexpr size_t OFF_GT = OFF_EGATE + 4194304;
constexpr size_t OFF_CST = OFF_GT + 16777216;
constexpr size_t OFF_NV = OFF_CST + 16777216;
constexpr size_t OFF_NST = OFF_NV + 262144;
constexpr size_t OFF_MLOC = OFF_NST + 262144;
constexpr size_t OFF_BLAST = OFF_MLOC + 4096;
constexpr size_t OFF_MST = OFF_BLAST + 4096;
constexpr size_t OFF_U16 = OFF_MST + 4096;
constexpr size_t OFF_V16 = OFF_U16 + 67108864;
constexpr size_t OFF_BAR = OFF_V16 + 67108864;
constexpr size_t WS_TOTAL = OFF_BAR + 32768;

constexpr int SMEM_BYTES = 48128;

struct Params {
  const float *x_prompt, *x_sample, *cache_k, *cache_v, *state_C, *state_n, *state_m, *c, *c_ctx;
  const float *w_mod, *b_mod, *norm1_g, *norm2_g, *w_in, *gate_b, *attn_sink, *mlstm_norm_g, *pool_w, *pool_scale, *w_out,
      *peer_wq, *peer_keys, *peer_u, *peer_v, *final_norm_g;
  float* out;
  char* ws;
  int phase_lo, phase_hi;
};

DI bf16_t f2bf(float x) { return __builtin_bit_cast(bf16_t, (__bf16)x); }
DI float bf2f(bf16_t b) { return __uint_as_float(((unsigned)b) << 16); }
DI unsigned pack2(float a, float b) { bf16x2_t v = {(__bf16)a, (__bf16)b}; return __builtin_bit_cast(unsigned, v); }
DI float bflo(unsigned u) { return __uint_as_float(u << 16); }
DI float bfhi(unsigned u) { return __uint_as_float(u & 0xffff0000u); }

template <int N> DI float dpp_ror(float v) {
  return __builtin_bit_cast(float, __builtin_amdgcn_update_dpp(0, __builtin_bit_cast(int, v), 0x120 + N, 0xF, 0xF, false));
}
DI float g16_sum(float v) {
  v += dpp_ror<8>(v); v += dpp_ror<4>(v); v += dpp_ror<2>(v); v += dpp_ror<1>(v);
  return v;
}
DI float g16_max(float v) {
  v = fmaxf(v, dpp_ror<8>(v)); v = fmaxf(v, dpp_ror<4>(v)); v = fmaxf(v, dpp_ror<2>(v)); v = fmaxf(v, dpp_ror<1>(v));
  return v;
}
DI float wave_sum(float v) {
  v = g16_sum(v);
  v += __shfl_xor(v, 16); v += __shfl_xor(v, 32);
  return v;
}
DI float wave_max(float v) {
  v = g16_max(v);
  v = fmaxf(v, __shfl_xor(v, 16)); v = fmaxf(v, __shfl_xor(v, 32));
  return v;
}

DI void load8(const bf16_t* p, float (&v)[8]) {
  uint4 r = *(const uint4*)p;
  v[0] = bflo(r.x); v[1] = bfhi(r.x); v[2] = bflo(r.y); v[3] = bfhi(r.y);
  v[4] = bflo(r.z); v[5] = bfhi(r.z); v[6] = bflo(r.w); v[7] = bfhi(r.w);
}
DI void load8(const float* p, float (&v)[8]) {
  float4 a = *(const float4*)p, b = *(const float4*)(p + 4);
  v[0] = a.x; v[1] = a.y; v[2] = a.z; v[3] = a.w; v[4] = b.x; v[5] = b.y; v[6] = b.z; v[7] = b.w;
}
DI uint4 pack8(const float (&v)[8]) {
  uint4 r; r.x = pack2(v[0], v[1]); r.y = pack2(v[2], v[3]); r.z = pack2(v[4], v[5]); r.w = pack2(v[6], v[7]); return r;
}

template <typename ST, bool TRANS>
DI void load_tile(bf16_t* sT, const ST* src, long rstride, float scale, const float* rowscale, int tid) {
  if (!TRANS) {
    const int row = tid >> 2;
    if (sizeof(ST) == 2 && rowscale == nullptr && scale == 1.f) {
#pragma unroll
      for (int pp = 0; pp < 2; ++pp) {
        const int d0 = ((tid & 3) * 2 + pp) * 8;
        *(uint4*)(sT + row * LDT + d0) = *(const uint4*)(src + (long)row * rstride + d0);
      }
      return;
    }
    const float sc = scale * (rowscale ? rowscale[row] : 1.f);
#pragma unroll
    for (int pp = 0; pp < 2; ++pp) {
      const int d0 = ((tid & 3) * 2 + pp) * 8;
      float v[8];
      load8(src + (long)row * rstride + d0, v);
#pragma unroll
      for (int i = 0; i < 8; ++i) v[i] *= sc;
      *(uint4*)(sT + row * LDT + d0) = pack8(v);
    }
  } else {
    const int rp = tid >> 3, dc = tid & 7;
    const float sc0 = scale * (rowscale ? rowscale[2 * rp] : 1.f), sc1 = scale * (rowscale ? rowscale[2 * rp + 1] : 1.f);
    float v0[8], v1[8];
    load8(src + (long)(2 * rp) * rstride + dc * 8, v0);
    load8(src + (long)(2 * rp + 1) * rstride + dc * 8, v1);
#pragma unroll
    for (int i = 0; i < 8; ++i) *(unsigned*)(sT + (dc * 8 + i) * LDT + 2 * rp) = pack2(v0[i] * sc0, v1[i] * sc1);
  }
}

DI void load_tile_rope(bf16_t* sT, const bf16_t* src, long rstride, int pos0, float scale, const float2* ropeT, int tid) {
  const int row = tid >> 2, pp = tid & 3, half = pp >> 1, sub = pp & 1;
  const int d1 = half * 32 + sub * 8, d2 = d1 + 16;
  float x1[8], x2[8], o1[8], o2[8];
  load8(src + (long)row * rstride + d1, x1);
  load8(src + (long)row * rstride + d2, x2);
  const int pos = pos0 + row;
  const int pp_ = half == 0 ? (pos >> 6) : (pos & 63);
#pragma unroll
  for (int i = 0; i < 8; ++i) {
    float2 cs = ropeT[pp_ * 16 + sub * 8 + i];
    o1[i] = (x1[i] * cs.x - x2[i] * cs.y) * scale;
    o2[i] = (x2[i] * cs.x + x1[i] * cs.y) * scale;
  }
  *(uint4*)(sT + row * LDT + d1) = pack8(o1);
  *(uint4*)(sT + row * LDT + d2) = pack8(o2);
}

template <int NT, int KS>
DI void mma_lds(const bf16_t* sA, const bf16_t* sB, f32x4 (&acc)[NT], int lane) {
  const int r = lane & 15, q = lane >> 4;
#pragma unroll
  for (int ks = 0; ks < KS; ++ks) {
    bf16x8 a = *(const bf16x8*)(sA + r * LDT + ks * 32 + q * 8);
#pragma unroll
    for (int nt = 0; nt < NT; ++nt) {
      bf16x8 b = *(const bf16x8*)(sB + (nt * 16 + r) * LDT + ks * 32 + q * 8);
      acc[nt] = __builtin_amdgcn_mfma_f32_16x16x32_bf16(a, b, acc[nt], 0, 0, 0);
    }
  }
}

DI int tok_ci(int row) { return row < TC ? 0 : 1 + ((row - TC) >> 11); }

DI int otid() { int t = (int)threadIdx.x; asm volatile("" : "+v"(t)); return t; }

DI void load_row16(const float* row, int lane, float (&v)[16]) {
  float a[8], b[8];
  load8(row + lane * 16, a);
  load8(row + lane * 16 + 8, b);
#pragma unroll
  for (int i = 0; i < 8; ++i) { v[i] = a[i]; v[8 + i] = b[i]; }
}
DI void store_row16(float* row, int lane, const float (&v)[16]) {
  *(float4*)(row + lane * 16) = make_float4(v[0], v[1], v[2], v[3]);
  *(float4*)(row + lane * 16 + 4) = make_float4(v[4], v[5], v[6], v[7]);
  *(float4*)(row + lane * 16 + 8) = make_float4(v[8], v[9], v[10], v[11]);
  *(float4*)(row + lane * 16 + 12) = make_float4(v[12], v[13], v[14], v[15]);
}

DI void norm_mod_emit(const float (&xv)[16], int lane, const float* g, const float* sc, const float* sh, bf16_t* hrow,
                      const float* WgT, float* gates_row) {
  float ss = 0.f;
#pragma unroll
  for (int i = 0; i < 16; ++i) ss += xv[i] * xv[i];
  ss = wave_sum(ss);
  const float rstd = rsqrtf(ss * (1.f / 1024.f) + EPS);
  float gv[16], scv[16], shv[16], hv[16];
  load_row16(g, lane, gv);
  load_row16(sc, lane, scv);
  load_row16(sh, lane, shv);
#pragma unroll
  for (int i = 0; i < 16; ++i) hv[i] = xv[i] * rstd * gv[i] * (1.f + scv[i]) + shv[i];
  {
    float a[8], b[8];
#pragma unroll
    for (int i = 0; i < 8; ++i) { a[i] = hv[i]; b[i] = hv[8 + i]; }
    *(uint4*)(hrow + lane * 16) = pack8(a);
    *(uint4*)(hrow + lane * 16 + 8) = pack8(b);
  }
  if (WgT) {
    float d[16];
    const float* wg = WgT;
    asm volatile("" : "+s"(wg));
#pragma unroll
    for (int j = 0; j < 16; ++j) {
      float wv[16];
      load_row16(wg + j * 1024, lane, wv);
      float s = 0.f;
#pragma unroll
      for (int i = 0; i < 16; ++i) s += hv[i] * wv[i];
      d[j] = s;
    }
#pragma unroll
    for (int j = 0; j < 8; ++j) {
      const bool up = lane & 32;
      float send = up ? d[j] : d[j + 8], keep = up ? d[j + 8] : d[j];
      d[j] = keep + __shfl_xor(send, 32);
    }
#pragma unroll
    for (int j = 0; j < 4; ++j) {
      const bool up = lane & 16;
      float send = up ? d[j] : d[j + 4], keep = up ? d[j + 4] : d[j];
      d[j] = keep + __shfl_xor(send, 16);
    }
#pragma unroll
    for (int j = 0; j < 2; ++j) {
      const bool up = lane & 8;
      float send = up ? d[j] : d[j + 2], keep = up ? d[j + 2] : d[j];
      d[j] = keep + __shfl_xor(send, 8);
    }
    {
      const bool up = lane & 4;
      float send = up ? d[0] : d[1], keep = up ? d[1] : d[0];
      d[0] = keep + __shfl_xor(send, 4);
    }
    d[0] += __shfl_xor(d[0], 2);
    d[0] += __shfl_xor(d[0], 1);
    if ((lane & 3) == 0) {
      const int j = ((lane & 32) ? 8 : 0) + ((lane & 16) ? 4 : 0) + ((lane & 8) ? 2 : 0) + ((lane & 4) ? 1 : 0);
      gates_row[j] = d[0];
    }
  }
}

DI void transpose_tile(const float* src, int ld_src, int k0, int ncol0, bf16_t* dst  , int nrow0, float* sT, int tid) {
  __syncthreads();
#pragma unroll
  for (int r = 0; r < 16; ++r) {
    const int k = r * 4 + (tid >> 6), n = tid & 63;
    sT[k * 65 + n] = src[(size_t)(k0 + k) * ld_src + ncol0 + n];
  }
  __syncthreads();
#pragma unroll
  for (int r = 0; r < 2; ++r) {
    const int chunk = tid + 256 * r, n = chunk >> 3, kc = chunk & 7;
    float v[8];
#pragma unroll
    for (int i = 0; i < 8; ++i) v[i] = sT[(kc * 8 + i) * 65 + n];
    *(uint4*)(dst + (size_t)(nrow0 + n) * 1024 + k0 + kc * 8) = pack8(v);
  }
}

DI void phase_prologue(const Params& p, char* smem) {
  const int tid = otid();
  float* sT = (float*)smem;
  constexpr int N_TR = 2560, N_WG = 32, N_KEYS = 256, N_MOD = 192, N_ROPE = 1, N_UV = 0;
  constexpr int N_ALL = N_TR + N_WG + N_KEYS + N_MOD + N_ROPE + N_UV;
  for (int it = blockIdx.x; it < N_ALL; it += gridDim.x) {
    int i = it;
    if (i < N_TR) {
      const int l = i / 1280; int j = i % 1280;
      if (j < 512) {
        const int kt = j >> 5, nt = j & 31;
        const int n0 = nt * 64, col0 = n0 < 1792 ? n0 : n0 + 16;
        transpose_tile(p.w_in + (size_t)l * 1024 * 2064, 2064, kt * 64, col0, (bf16_t*)(p.ws + OFF_WINT) + (size_t)l * 2048 * 1024, n0, sT, tid);
      } else if (j < 768) {
        j -= 512; const int kt = j >> 4, nt = j & 15;
        transpose_tile(p.w_out + (size_t)l * 1024 * 1024, 1024, kt * 64, nt * 64, (bf16_t*)(p.ws + OFF_WOUTT) + (size_t)l * 1024 * 1024, nt * 64, sT, tid);
      } else {
        j -= 768; const int kt = j >> 5, nt = j & 31;
        transpose_tile(p.peer_wq + (size_t)l * 1024 * 2048, 2048, kt * 64, nt * 64, (bf16_t*)(p.ws + OFF_WQT) + (size_t)l * 2048 * 1024, nt * 64, sT, tid);
      }
      continue;
    }
    i -= N_TR;
    if (i < N_WG) {
      const int l = i >> 4, j = i & 15;
      float* dst = (float*)(p.ws + OFF_WGT) + (size_t)(l * 16 + j) * 1024;
#pragma unroll
      for (int r = 0; r < 4; ++r) { const int k = tid + 256 * r; dst[k] = p.w_in[((size_t)l * 1024 + k) * 2064 + 1792 + j]; }
      continue;
    }
    i -= N_WG;
    if (i < N_KEYS) {
      const size_t e0 = ((size_t)i * 256 + tid) * 8;
      float v[8]; load8(p.peer_keys + e0, v);
      *(uint4*)((bf16_t*)(p.ws + OFF_KEYS) + e0) = pack8(v);
      continue;
    }
    i -= N_KEYS;
    if (i < N_MOD) {
      const int l = i / 96, chunk = i % 96;
      float* sCond = sT;
      float* sRed = sT + 3072;
      __syncthreads();
      for (int e = tid; e < 3072; e += 256) {
        const int ci = e >> 10, k = e & 1023;
        const float cv = ci == 0 ? p.c_ctx[k] : p.c[(ci - 1) * 1024 + k];
        sCond[e] = cv / (1.f + __expf(-cv));
      }
      __syncthreads();
      const int kq = tid >> 6, cl = tid & 63, col = chunk * 64 + cl;
      float a0 = 0.f, a1 = 0.f, a2 = 0.f;
      const float* wp = p.w_mod + (size_t)l * 1024 * 6144 + col;
#pragma unroll 8
      for (int k = kq * 256; k < kq * 256 + 256; ++k) {
        const float w = wp[(size_t)k * 6144];
        a0 += sCond[k] * w; a1 += sCond[1024 + k] * w; a2 += sCond[2048 + k] * w;
      }
      sRed[(kq * 3 + 0) * 64 + cl] = a0; sRed[(kq * 3 + 1) * 64 + cl] = a1; sRed[(kq * 3 + 2) * 64 + cl] = a2;
      __syncthreads();
      if (tid < 192) {
        const int ci = tid >> 6, c2 = tid & 63;
        float s = 0.f;
#pragma unroll
        for (int q = 0; q < 4; ++q) s += sRed[(q * 3 + ci) * 64 + c2];
        const int cc = chunk * 64 + c2;
        ((float*)(p.ws + OFF_MOD))[(size_t)(l * 3 + ci) * 6144 + cc] = s + p.b_mod[l * 6144 + cc];
      }
      continue;
    }
    i -= N_MOD;
    if (i < N_ROPE) {
      float2* rt = (float2*)(p.ws + OFF_ROPE);
#pragma unroll
      for (int r = 0; r < 4; ++r) {
        const int e = tid + 256 * r, pos = e >> 4, j = e & 15;
        const float inv = powf(10000.f, -(float)j / 16.f);
        float s, c; sincosf((float)pos * inv, &s, &c);
        rt[e] = make_float2(c, s);
      }
      continue;
    }
  }
}

DI void convert_uv_item(const Params& p, int i, int tid) {
      const int tab = i >> 13; const size_t e0 = ((size_t)(i & 8191) * 256 + tid) * 16;
      const float* src = (tab ? p.peer_v : p.peer_u) + e0;
      const float scl = tab ? 64.f : 256.f;
      float v0[8], v1[8];
      load8(src, v0); load8(src + 8, v1);
      uint4 r;
      int w;
      w = 0; w = __builtin_amdgcn_cvt_pk_fp8_f32(v0[0] * scl, v0[1] * scl, w, false); w = __builtin_amdgcn_cvt_pk_fp8_f32(v0[2] * scl, v0[3] * scl, w, true); r.x = (unsigned)w;
      w = 0; w = __builtin_amdgcn_cvt_pk_fp8_f32(v0[4] * scl, v0[5] * scl, w, false); w = __builtin_amdgcn_cvt_pk_fp8_f32(v0[6] * scl, v0[7] * scl, w, true); r.y = (unsigned)w;
      w = 0; w = __builtin_amdgcn_cvt_pk_fp8_f32(v1[0] * scl, v1[1] * scl, w, false); w = __builtin_amdgcn_cvt_pk_fp8_f32(v1[2] * scl, v1[3] * scl, w, true); r.z = (unsigned)w;
      w = 0; w = __builtin_amdgcn_cvt_pk_fp8_f32(v1[4] * scl, v1[5] * scl, w, false); w = __builtin_amdgcn_cvt_pk_fp8_f32(v1[6] * scl, v1[7] * scl, w, true); r.w = (unsigned)w;
      const size_t R = e0 >> 10; const int d0 = (int)(e0 & 1023);
      const size_t dstb = ((((R >> 14) * 8 + (size_t)(d0 >> 7)) * 16384 + (R & 16383)) << 7) + (size_t)(d0 & 127);
      *(uint4*)((unsigned char*)(p.ws + (tab ? OFF_V16 : OFF_U16)) + dstb) = r;
}

DI void deferred_convert(const Params& p, int L, int min_block, int quota, bool drain, char* smem) {
  if ((int)blockIdx.x < min_block) return;
  unsigned* ctr = (unsigned*)(p.ws + OFF_BAR) + 4096 + 64 + L * 64;
  int* sb = (int*)smem;
  const int tid = otid();
  for (;;) {
    __syncthreads();
    if (tid == 0) sb[0] = (int)atomicAdd(ctr, (unsigned)quota);
    __syncthreads();
    const int base = sb[0];
    if (base >= 8192) break;
    const int end = min(base + quota, 8192);
    for (int j = base; j < end; ++j) convert_uv_item(p, (j >> 12) * 8192 + L * 4096 + (j & 4095), tid);
    if (!drain) break;
  }
}

DI void phase_norm(const Params& p, int l, int which) {
  const int lane = otid() & 63, gw = blockIdx.x * 4 + (otid() >> 6), nw = gridDim.x * 4;
  float* X = (float*)(p.ws + OFF_X);
  bf16_t* H = (bf16_t*)(p.ws + OFF_H);
  const float* mod = (const float*)(p.ws + OFF_MOD);
  for (int tok = gw; tok < T; tok += nw) {
    float xv[16];
    const int ci = tok_ci(tok);
    const float* md = mod + (size_t)(l * 3 + ci) * 6144;
    if (which == 0) {
      const float* src = tok < TC ? p.x_prompt + (size_t)tok * 1024 : p.x_sample + (size_t)(tok - TC) * 1024;
      load_row16(src, lane, xv);
      store_row16(X + (size_t)tok * 1024, lane, xv);
      norm_mod_emit(xv, lane, p.norm1_g + l * 1024, md + 1024, md, H + (size_t)tok * 1024,
                    (const float*)(p.ws + OFF_WGT) + (size_t)l * 16 * 1024, (float*)(p.ws + OFF_GATES) + (size_t)tok * 16);
    } else if (which == 1) {
      load_row16(X + (size_t)tok * 1024, lane, xv);
      norm_mod_emit(xv, lane, p.norm2_g + l * 1024, md + 4096, md + 3072, H + (size_t)tok * 1024, nullptr, nullptr);
    } else if (which == 2) {
      load_row16(X + (size_t)tok * 1024, lane, xv);
      norm_mod_emit(xv, lane, p.norm1_g + l * 1024, md + 1024, md, H + (size_t)tok * 1024,
                    (const float*)(p.ws + OFF_WGT) + (size_t)l * 16 * 1024, (float*)(p.ws + OFF_GATES) + (size_t)tok * 16);
    } else {
      load_row16(X + (size_t)tok * 1024, lane, xv);
      float ss = 0.f;
#pragma unroll
      for (int i = 0; i < 16; ++i) ss += xv[i] * xv[i];
      ss = wave_sum(ss);
      const float rstd = rsqrtf(ss * (1.f / 1024.f) + EPS);
      float gv[16];
      load_row16(p.final_norm_g, lane, gv);
#pragma unroll
      for (int i = 0; i < 16; ++i) xv[i] = xv[i] * rstd * gv[i];
      store_row16(p.out + (size_t)tok * 1024, lane, xv);
    }
  }
}

template <int EPI>
DI void phase_gemm(const Params& p, int l, const bf16_t* A, const bf16_t* Bt, int N, char* smem) {
  bf16_t* sA = (bf16_t*)smem;
  bf16_t* sB = sA + 128 * LDT;
  const int tid = otid(), lane = tid & 63, w = tid >> 6, wm = w >> 1, wn = w & 1, r = lane & 15, q = lane >> 4;
  const int ntiles = 64 * (N / 128);
  for (int tile = blockIdx.x; tile < ntiles; tile += gridDim.x) {
    const int tm = tile & 63, tn = tile >> 6;
    const int m0 = tm * 128, n0 = tn * 128;
    f32x4 acc[4][4];
#pragma unroll
    for (int mi = 0; mi < 4; ++mi)
#pragma unroll
      for (int ni = 0; ni < 4; ++ni) acc[mi][ni] = (f32x4){0.f, 0.f, 0.f, 0.f};
    u32x4 ra[4], rb[4];
    const int lrow = tid >> 3, lkc = tid & 7;
    const bf16_t* Ap = A + (size_t)(m0 + lrow) * 1024 + lkc * 8;
    const bf16_t* Bp = Bt + (size_t)(n0 + lrow) * 1024 + lkc * 8;
#pragma unroll
    for (int i = 0; i < 4; ++i) { ra[i] = *(const u32x4*)(Ap + (size_t)i * 32 * 1024); rb[i] = *(const u32x4*)(Bp + (size_t)i * 32 * 1024); }
    __syncthreads();
#pragma unroll
    for (int i = 0; i < 4; ++i) { *(u32x4*)(sA + (lrow + 32 * i) * LDT + lkc * 8) = ra[i]; *(u32x4*)(sB + (lrow + 32 * i) * LDT + lkc * 8) = rb[i]; }
    __syncthreads();
    for (int kt = 0; kt < 16; ++kt) {
      if (kt < 15) {
#pragma unroll
        for (int i = 0; i < 4; ++i) {
          ra[i] = *(const u32x4*)(Ap + (size_t)i * 32 * 1024 + (kt + 1) * 64);
          rb[i] = *(const u32x4*)(Bp + (size_t)i * 32 * 1024 + (kt + 1) * 64);
        }
      }
      __builtin_amdgcn_sched_barrier(0);
#pragma unroll
      for (int ks = 0; ks < 2; ++ks) {
        bf16x8 a[4], b[4];
#pragma unroll
        for (int mi = 0; mi < 4; ++mi) a[mi] = *(const bf16x8*)(sA + (wm * 64 + mi * 16 + r) * LDT + ks * 32 + q * 8);
#pragma unroll
        for (int ni = 0; ni < 4; ++ni) b[ni] = *(const bf16x8*)(sB + (wn * 64 + ni * 16 + r) * LDT + ks * 32 + q * 8);
#pragma unroll
        for (int mi = 0; mi < 4; ++mi)
#pragma unroll
          for (int ni = 0; ni < 4; ++ni) acc[mi][ni] = __builtin_amdgcn_mfma_f32_16x16x32_bf16(b[ni], a[mi], acc[mi][ni], 0, 0, 0);
      }
      __syncthreads();
      if (kt < 15) {
#pragma unroll
        for (int i = 0; i < 4; ++i) { *(u32x4*)(sA + (lrow + 32 * i) * LDT + lkc * 8) = ra[i]; *(u32x4*)(sB + (lrow + 32 * i) * LDT + lkc * 8) = rb[i]; }
        __syncthreads();
      }
    }
#pragma unroll
    for (int mi = 0; mi < 4; ++mi) {
      const int row = m0 + wm * 64 + mi * 16 + r;
#pragma unroll
      for (int ni = 0; ni < 4; ++ni) {
        const int col = n0 + wn * 64 + ni * 16 + q * 4;
        const f32x4 v = acc[mi][ni];
        if (EPI == 0) {
          *(uint2*)((bf16_t*)(p.ws + OFF_P) + (size_t)row * NP + col) = make_uint2(pack2(v[0], v[1]), pack2(v[2], v[3]));
          if (row < TC && col >= 512 && col < 768) {
            const int b = row >> 8, s = row & 255, isv = col >= 640, cc = col - (isv ? 640 : 512);
            *(float4*)(p.out + (isv ? OUT_CV : OUT_CK) + ((size_t)(b * 2 + l) * 256 + s) * 128 + cc) = make_float4(v[0], v[1], v[2], v[3]);
          }
        } else if (EPI == 1) {
          const float4 g1 = *(const float4*)((const float*)(p.ws + OFF_MOD) + (size_t)(l * 3 + tok_ci(row)) * 6144 + 2048 + col);
          float4* xp = (float4*)((float*)(p.ws + OFF_X) + (size_t)row * 1024 + col);
          float4 xv = *xp;
          xv.x += g1.x * v[0]; xv.y += g1.y * v[1]; xv.z += g1.z * v[2]; xv.w += g1.w * v[3];
          *xp = xv;
        } else {
          *(uint2*)((bf16_t*)(p.ws + OFF_QP) + (size_t)row * 2048 + col) = make_uint2(pack2(v[0], v[1]), pack2(v[2], v[3]));
        }
      }
    }
  }
}

DI void attn_item(const Params& p, int l, int item, char* smem) {
  bf16_t* sQ = (bf16_t*)smem;
  bf16_t* sK = sQ + 64 * LDT;
  bf16_t* sVt = sK + 64 * LDT;
  bf16_t* sP = sVt + 64 * LDT;
  const int tid = otid(), lane = tid & 63, w = tid >> 6, r = lane & 15, q = lane >> 4;
  const bool lat = item < 512;
  int b, h, qb, L, rowbase;
  if (lat) { b = item >> 8; h = (item >> 5) & 7; qb = item & 31; L = 2048; rowbase = TC + b * 2048; }
  else { const int it = item - 512; b = it >> 5; h = (it >> 2) & 7; qb = it & 3; L = 256; rowbase = b * 256; }
  const int kv = h >> 2, q0 = qb * 64;
  const bf16_t* P = (const bf16_t*)(p.ws + OFF_P);
  const float2* ropeT = (const float2*)(p.ws + OFF_ROPE);
  __syncthreads();
  if (lat) load_tile_rope(sQ, P + (size_t)(rowbase + q0) * NP + PC_QA + h * 64, NP, q0, 0.125f, ropeT, tid);
  else load_tile<bf16_t, false>(sQ, P + (size_t)(rowbase + q0) * NP + PC_QA + h * 64, NP, 0.125f, nullptr, tid);
  const float sink = p.attn_sink[l * 8 + h];
  __syncthreads();
  bf16x8 qf[2];
  qf[0] = *(const bf16x8*)(sQ + (w * 16 + r) * LDT + q * 8);
  qf[1] = *(const bf16x8*)(sQ + (w * 16 + r) * LDT + 32 + q * 8);
  float m_ = sink, l_ = (q == 0) ? 1.f : 0.f;
  f32x4 o[4];
#pragma unroll
  for (int et = 0; et < 4; ++et) o[et] = (f32x4){0.f, 0.f, 0.f, 0.f};
  const int nkt = lat ? 9 : 4;
  const int qp = q0 + w * 16 + r;
  for (int kt = 0; kt < nkt; ++kt) {
    int kpos0; bool band = false, cache = false;
    if (!lat) kpos0 = kt * 64;
    else if (kt < 5) { kpos0 = q0 - 128 + kt * 64; band = true; if (kpos0 < 0 || kpos0 >= L) continue; }
    else { cache = true; kpos0 = (kt - 5) * 64; }
    __syncthreads();
    if (cache) {
      const size_t off = (((size_t)(b * 2 + l) * 256 + kpos0) * 2 + kv) * 64;
      load_tile<float, false>(sK, p.cache_k + off, 128, 1.f, nullptr, tid);
      load_tile<float, true>(sVt, p.cache_v + off, 128, 1.f, nullptr, tid);
    } else {
      const bf16_t* ks = P + (size_t)(rowbase + kpos0) * NP + PC_KA + kv * 64;
      if (lat) load_tile_rope(sK, ks, NP, kpos0, 1.f, ropeT, tid);
      else load_tile<bf16_t, false>(sK, ks, NP, 1.f, nullptr, tid);
      load_tile<bf16_t, true>(sVt, P + (size_t)(rowbase + kpos0) * NP + PC_VA + kv * 64, NP, 1.f, nullptr, tid);
    }
    __syncthreads();
    f32x4 sc[4];
#pragma unroll
    for (int nt = 0; nt < 4; ++nt) {
      sc[nt] = (f32x4){0.f, 0.f, 0.f, 0.f};
#pragma unroll
      for (int ks = 0; ks < 2; ++ks) {
        const bf16x8 kf = *(const bf16x8*)(sK + (nt * 16 + r) * LDT + ks * 32 + q * 8);
        sc[nt] = __builtin_amdgcn_mfma_f32_16x16x32_bf16(kf, qf[ks], sc[nt], 0, 0, 0);
      }
    }
    if (band) {
#pragma unroll
      for (int nt = 0; nt < 4; ++nt)
#pragma unroll
        for (int jj = 0; jj < 4; ++jj) {
          const int d = qp - (kpos0 + nt * 16 + q * 4 + jj);
          if (d > 128 || d < -128) sc[nt][jj] = -INFINITY;
        }
    }
    float mx = -INFINITY;
#pragma unroll
    for (int nt = 0; nt < 4; ++nt)
#pragma unroll
      for (int jj = 0; jj < 4; ++jj) mx = fmaxf(mx, sc[nt][jj]);
    mx = fmaxf(mx, __shfl_xor(mx, 16));
    mx = fmaxf(mx, __shfl_xor(mx, 32));
    const float mn = fmaxf(m_, mx);
    const float alpha = __expf(m_ - mn);
    m_ = mn;
    float ps = 0.f;
    float pv[4][4];
#pragma unroll
    for (int nt = 0; nt < 4; ++nt)
#pragma unroll
      for (int jj = 0; jj < 4; ++jj) { pv[nt][jj] = __expf(sc[nt][jj] - mn); ps += pv[nt][jj]; }
    l_ = l_ * alpha + ps;
#pragma unroll
    for (int et = 0; et < 4; ++et) o[et] *= alpha;
#pragma unroll
    for (int ks = 0; ks < 2; ++ks) {
      u32x4 pk;
      pk[0] = pack2(pv[2 * ks][0], pv[2 * ks][1]); pk[1] = pack2(pv[2 * ks][2], pv[2 * ks][3]);
      pk[2] = pack2(pv[2 * ks + 1][0], pv[2 * ks + 1][1]); pk[3] = pack2(pv[2 * ks + 1][2], pv[2 * ks + 1][3]);
      const bf16x8 pf = __builtin_bit_cast(bf16x8, pk);
#pragma unroll
      for (int et = 0; et < 4; ++et) {
        const bf16_t* vrow = sVt + (et * 16 + r) * LDT + ks * 32 + q * 4;
        const uint2 v0 = *(const uint2*)(vrow), v1 = *(const uint2*)(vrow + 16);
        u32x4 vk; vk[0] = v0.x; vk[1] = v0.y; vk[2] = v1.x; vk[3] = v1.y;
        o[et] = __builtin_amdgcn_mfma_f32_16x16x32_bf16(__builtin_bit_cast(bf16x8, vk), pf, o[et], 0, 0, 0);
      }
    }
  }
  float lt = l_;
  lt += __shfl_xor(lt, 16);
  lt += __shfl_xor(lt, 32);
  const float inv = 1.f / lt;
  bf16_t* mix = (bf16_t*)(p.ws + OFF_MIX);
  const size_t row = rowbase + qp;
#pragma unroll
  for (int et = 0; et < 4; ++et)
    *(uint2*)(mix + row * 1024 + h * 64 + et * 16 + q * 4) = make_uint2(pack2(o[et][0] * inv, o[et][1] * inv), pack2(o[et][2] * inv, o[et][3] * inv));
}

DI float logsigmoid(float x) { return fminf(x, 0.f) - log1pf(__expf(-fabsf(x))); }

struct MItem { int b, h, dir, c, nc, rowbase; bool lat; };
DI MItem mitem_decode(int item) {
  MItem m;
  if (item < 512) { const int seq = item >> 2; m.c = item & 3; m.b = seq >> 3; m.h = (seq >> 1) & 3; m.dir = seq & 1; m.nc = 4; m.rowbase = m.b * 256; m.lat = false; }
  else { const int it = item - 512, s2 = it >> 5; m.c = it & 31; m.b = s2 >> 3; m.h = (s2 >> 1) & 3; m.dir = s2 & 1; m.nc = 32; m.rowbase = TC + m.b * 2048; m.lat = true; }
  return m;
}

DI void chunk_gates(const Params& p, int l, int row0, int h, int dir, int lane, float& bt, float& ig, float& tot) {
  const float* g = (const float*)(p.ws + OFF_GATES) + (size_t)(row0 + lane) * 16;
  ig = g[dir * 8 + h] + p.gate_b[l * 16 + dir * 8 + h];
  const float fg = g[dir * 8 + 4 + h] + p.gate_b[l * 16 + dir * 8 + 4 + h];
  const float lf = logsigmoid(fg);
  float pre = lf;
#pragma unroll
  for (int d = 1; d < 64; d <<= 1) { const float t = __shfl_up(pre, d); if (lane >= d) pre += t; }
  tot = __shfl(pre, 63);
  bt = dir ? (tot - pre + lf) : pre;
}

DI void mlstm_local_item(const Params& p, int l, int item, char* smem) {
  bf16_t* sKat = (bf16_t*)smem;
  bf16_t* sVt = sKat + 64 * LDT;
  float* sa = (float*)(sVt + 64 * LDT);
  const int tid = otid(), lane = tid & 63, w = tid >> 6, r = lane & 15, q = lane >> 4;
  const MItem m = mitem_decode(item);
  const int c_o = m.dir ? m.nc - 1 - m.c : m.c;
  const int row0 = m.rowbase + c_o * 64;
  const bf16_t* P = (const bf16_t*)(p.ws + OFF_P);
  __syncthreads();
  if (w == 0) {
    float bt, ig, tot;
    chunk_gates(p, l, row0, m.h, m.dir, lane, bt, ig, tot);
    const float wlog = tot - bt + ig;
    const float mloc = wave_max(wlog);
    sa[lane] = __expf(wlog - mloc);
    if (lane == 0) { ((float*)(p.ws + OFF_MLOC))[item] = mloc; ((float*)(p.ws + OFF_BLAST))[item] = tot; }
  }
  __syncthreads();
  load_tile<bf16_t, true>(sKat, P + (size_t)row0 * NP + PC_KM + m.h * 64, NP, 0.125f, sa, tid);
  load_tile<bf16_t, true>(sVt, P + (size_t)row0 * NP + PC_VM + m.h * 64, NP, 1.f, nullptr, tid);
  __syncthreads();
  f32x4 acc[4];
#pragma unroll
  for (int nt = 0; nt < 4; ++nt) acc[nt] = (f32x4){0.f, 0.f, 0.f, 0.f};
  mma_lds<4, 2>(sVt + w * 16 * LDT, sKat, acc, lane);
  float* Gt = (float*)(p.ws + OFF_GT) + (size_t)item * 4096;
#pragma unroll
  for (int nt = 0; nt < 4; ++nt)
#pragma unroll
    for (int j = 0; j < 4; ++j) Gt[(w * 16 + q * 4 + j) * 64 + nt * 16 + r] = acc[nt][j];
  if (tid < 64) {
    float s = 0.f;
    for (int i = 0; i < 64; ++i) s += bf2f(sKat[tid * LDT + i]);
    ((float*)(p.ws + OFF_NV))[item * 64 + tid] = s;
  }
}

DI void pool_item(const Params& p, int l, int item, char* smem) {
  float* sX = (float*)smem;
  bf16_t* sD = (bf16_t*)(smem + 20480);
  bf16_t* sWt = sD + 64 * LDT;
  const int tid = otid(), lane = tid & 63, w = tid >> 6, r = lane & 15, q = lane >> 4;
  const int tt = item >> 2, g = item & 3;
  const int row0 = tt * 64;
  const int L = row0 < TC ? 256 : 2048;
  const int pos0 = row0 < TC ? (row0 & 255) : ((row0 - TC) & 2047);
  const bf16_t* P = (const bf16_t*)(p.ws + OFF_P);
  __syncthreads();
  for (int ch = tid; ch < 640; ch += 256) {
    const int rr = ch >> 3, dc = ch & 7;
    const int pos = pos0 - 8 + rr;
    float v[8];
    if (pos >= 0 && pos < L) load8(P + (size_t)(row0 - 8 + rr) * NP + PC_XP + g * 64 + dc * 8, v);
    else {
#pragma unroll
      for (int i = 0; i < 8; ++i) v[i] = 0.f;
    }
    *(float4*)(sX + rr * 64 + dc * 8) = make_float4(v[0], v[1], v[2], v[3]);
    *(float4*)(sX + rr * 64 + dc * 8 + 4) = make_float4(v[4], v[5], v[6], v[7]);
  }
  {
    const float* pw = p.pool_w + (size_t)(l * 4 + g) * 4096;
#pragma unroll
    for (int rr = 0; rr < 16; ++rr) { const int in = (tid >> 6) + 4 * rr, out = tid & 63; sWt[out * LDT + in] = f2bf(pw[in * 64 + out]); }
  }
  __syncthreads();
  const int hw = 1 << g;
  {
    const int ch = tid & 63, i0 = (tid >> 6) * 16;
    int pos = pos0 + i0;
    int lo = max(pos - hw, 0), hi = min(pos + hw, L);
    float sum = 0.f;
    for (int u = lo; u < hi; ++u) sum += sX[(u - pos0 + 8) * 64 + ch];
#pragma unroll 4
    for (int rr = 0; rr < 16; ++rr) {
      const int i = i0 + rr;
      sD[i * LDT + ch] = f2bf(sum / (float)(hi - lo) - sX[(i + 8) * 64 + ch]);
      const int lo2 = max(pos + 1 - hw, 0), hi2 = min(pos + 1 + hw, L);
      if (hi2 > hi) sum += sX[(hi2 - 1 - pos0 + 8) * 64 + ch];
      if (lo2 > lo) sum -= sX[(lo - pos0 + 8) * 64 + ch];
      lo = lo2; hi = hi2; ++pos;
    }
  }
  __syncthreads();
  f32x4 acc[4];
#pragma unroll
  for (int nt = 0; nt < 4; ++nt) acc[nt] = (f32x4){0.f, 0.f, 0.f, 0.f};
  mma_lds<4, 2>(sD + w * 16 * LDT, sWt, acc, lane);
  bf16_t* mix = (bf16_t*)(p.ws + OFF_MIX);
#pragma unroll
  for (int nt = 0; nt < 4; ++nt) {
    const int oc = nt * 16 + r;
    const float ps = p.pool_scale[l * 256 + g * 64 + oc];
#pragma unroll
    for (int j = 0; j < 4; ++j) mix[(size_t)(row0 + w * 16 + q * 4 + j) * 1024 + 768 + g * 64 + oc] = f2bf(acc[nt][j] * ps);
  }
}

DI void phase_mixers(const Params& p, int l, char* smem) {
  constexpr int N_LAT = 512, N_ATT = 1024, N_ML = 1024, N_POOL = 512;
  const int G = gridDim.x, bid = blockIdx.x;
  const int Gl = G >= 3 ? (G * 2) / 3 : G;
  if (Gl == G) { for (int it = bid; it < N_ATT; it += G) attn_item(p, l, it, smem); }
  else if (bid < Gl) { for (int it = bid; it < N_LAT; it += Gl) attn_item(p, l, it, smem); }
  else { for (int it = N_LAT + (bid - Gl); it < N_ATT; it += G - Gl) attn_item(p, l, it, smem); }
  for (int it = bid; it < N_ML; it += G) mlstm_local_item(p, l, it, smem);
  for (int it = (bid + 2 * G - 256) % G; it < N_POOL; it += G) pool_item(p, l, it, smem);
}

DI void phase_scan(const Params& p, int l) {
  const int tid = otid();
  const float* Gt = (const float*)(p.ws + OFF_GT);
  const float* NV = (const float*)(p.ws + OFF_NV);
  const float* MLOC = (const float*)(p.ws + OFF_MLOC);
  const float* BL = (const float*)(p.ws + OFF_BLAST);
  float* CST = (float*)(p.ws + OFF_CST);
  float* NST = (float*)(p.ws + OFF_NST);
  float* MST = (float*)(p.ws + OFF_MST);
  for (int it = blockIdx.x; it < 144 * 17; it += gridDim.x) {
    const int seq = it / 17, part = it % 17;
    const bool isC = part < 16;
    if (!isC && tid >= 64) continue;
    const bool lat = seq >= 128;
    int b, h, dir, nc, itembase;
    if (!lat) { b = seq >> 3; h = (seq >> 1) & 3; dir = seq & 1; nc = 4; itembase = seq * 4; }
    else { const int s2 = seq - 128; b = s2 >> 3; h = (s2 >> 1) & 3; dir = s2 & 1; nc = 32; itembase = 512 + s2 * 32; }
    const int idx = part * 256 + tid, e = idx >> 6, d = isC ? (idx & 63) : tid;
    float m = 0.f, val = 0.f;
    if (lat) {
      const size_t sb = ((size_t)(b * 2 + l) * 2 + dir) * 4 + h;
      m = p.state_m[sb];
      val = isC ? p.state_C[(sb * 64 + d) * 64 + e] : p.state_n[sb * 64 + d];
    }
    for (int c0 = 0; c0 < nc; c0 += 4) {
      float g[4], ml[4], bl4[4];
#pragma unroll
      for (int u = 0; u < 4; ++u) {
        const int item = itembase + c0 + u;
        ml[u] = MLOC[item]; bl4[u] = BL[item];
        g[u] = isC ? Gt[(size_t)item * 4096 + idx] : NV[item * 64 + d];
      }
#pragma unroll
      for (int u = 0; u < 4; ++u) {
        const int item = itembase + c0 + u;
        if (isC) { CST[(size_t)item * 4096 + idx] = val; if (idx == 0) MST[item] = m; }
        else NST[item * 64 + d] = val;
        const float mn = fmaxf(bl4[u] + m, ml[u]);
        const float decay = __expf(bl4[u] + m - mn), sc = __expf(ml[u] - mn);
        val = decay * val + sc * g[u];
        m = mn;
      }
    }
    if (!lat) {
      const size_t sb = ((size_t)(b * 2 + l) * 2 + dir) * 4 + h;
      if (isC) { p.out[OUT_SC + (sb * 64 + d) * 64 + e] = val; if (idx == 0) p.out[OUT_SM + sb] = m; }
      else p.out[OUT_SN + sb * 64 + d] = val;
    }
  }
}

DI void phase_mlstm_out(const Params& p, int l, char* smem) {
  bf16_t* sQ = (bf16_t*)smem;
  bf16_t* sK = sQ + 64 * LDT;
  bf16_t* sVt = sK + 64 * LDT;
  bf16_t* sCt = sVt + 64 * LDT;
  bf16_t* sW = sCt + 64 * LDT;
  float* sn = (float*)(sW + 64 * LDT);
  float* sb = sn + 64;
  float* sig = sb + 64;
  const int tid = otid(), lane = tid & 63, w = tid >> 6, r = lane & 15, q = lane >> 4;
  const bf16_t* P = (const bf16_t*)(p.ws + OFF_P);
  bf16_t* sWw = sW + w * 16 * LDT;
  for (int item = blockIdx.x; item < 512; item += gridDim.x) {
    int b, h, c_o, nc, rowbase; bool lat = item < 256;
    if (lat) { b = item >> 7; h = (item >> 5) & 3; c_o = item & 31; nc = 32; rowbase = TC + b * 2048; }
    else { const int it = item - 256; b = it >> 4; h = (it >> 2) & 3; c_o = it & 3; nc = 4; rowbase = b * 256; }
    const int row0 = rowbase + c_o * 64;
    f32x4 hacc[4];
#pragma unroll
    for (int nt = 0; nt < 4; ++nt) hacc[nt] = (f32x4){0.f, 0.f, 0.f, 0.f};
    for (int dir = 0; dir < 2; ++dir) {
      const int cc = dir ? nc - 1 - c_o : c_o;
      const int sitem = lat ? 512 + (b * 8 + h * 2 + dir) * 32 + cc : (b * 8 + h * 2 + dir) * 4 + cc;
      __syncthreads();
      if (w == 0) {
        float bt, ig, tot;
        chunk_gates(p, l, row0, h, dir, lane, bt, ig, tot);
        sb[lane] = bt; sig[lane] = ig;
      }
      if (dir == 0) {
        load_tile<bf16_t, false>(sQ, P + (size_t)row0 * NP + PC_QM + h * 64, NP, 1.f, nullptr, tid);
        load_tile<bf16_t, false>(sK, P + (size_t)row0 * NP + PC_KM + h * 64, NP, 0.125f, nullptr, tid);
        load_tile<bf16_t, true>(sVt, P + (size_t)row0 * NP + PC_VM + h * 64, NP, 1.f, nullptr, tid);
      }
      float m0 = 0.f;
      {
        const int itembase = sitem - cc;
        const size_t sbi = ((size_t)(b * 2 + l) * 2 + dir) * 4 + h;
        const int e_ = tid >> 2;
        const float* Gt = (const float*)(p.ws + OFF_GT);
        const float* NV = (const float*)(p.ws + OFF_NV);
        const float* MLOC = (const float*)(p.ws + OFF_MLOC);
        const float* BL = (const float*)(p.ws + OFF_BLAST);
        const int nsteps = (!lat && cc == nc - 1) ? nc : cc;
#pragma unroll 1
        for (int half = 0; half < 2; ++half) {
          const int dq = (tid & 3) * 16 + half * 8;
          float val[8], nval = 0.f, m = 0.f;
#pragma unroll
          for (int i = 0; i < 8; ++i) val[i] = 0.f;
          if (lat) {
            m = p.state_m[sbi];
#pragma unroll
            for (int i = 0; i < 8; ++i) val[i] = p.state_C[(sbi * 64 + dq + i) * 64 + e_];
            if (half == 0 && tid < 64) nval = p.state_n[sbi * 64 + tid];
          }
          for (int c0 = 0; c0 < cc; c0 += 4) {
            float g4[4][8], ml4[4], bl4[4], nv4[4];
#pragma unroll
            for (int u = 0; u < 4; ++u) {
              const int it2 = itembase + min(c0 + u, cc - 1);
              ml4[u] = MLOC[it2]; bl4[u] = BL[it2];
              load8(Gt + (size_t)it2 * 4096 + e_ * 64 + dq, g4[u]);
              nv4[u] = (half == 0 && tid < 64) ? NV[it2 * 64 + tid] : 0.f;
            }
#pragma unroll
            for (int u = 0; u < 4; ++u) {
              if (c0 + u < cc) {
                const float mn = fmaxf(bl4[u] + m, ml4[u]);
                const float decay = __expf(bl4[u] + m - mn), sc = __expf(ml4[u] - mn);
#pragma unroll
                for (int i = 0; i < 8; ++i) val[i] = decay * val[i] + sc * g4[u][i];
                nval = decay * nval + sc * nv4[u];
                m = mn;
              }
            }
          }
          *(uint4*)(sCt + e_ * LDT + dq) = pack8(val);
          if (half == 0 && tid < 64) sn[tid] = nval;
          m0 = m;
          if (nsteps != cc) {
            const int it2 = itembase + cc;
            const float mloc = MLOC[it2], bl = BL[it2];
            const float mn = fmaxf(bl + m, mloc);
            const float decay = __expf(bl + m - mn), sc = __expf(mloc - mn);
            float g0[8];
            load8(Gt + (size_t)it2 * 4096 + e_ * 64 + dq, g0);
#pragma unroll
            for (int i = 0; i < 8; ++i) val[i] = decay * val[i] + sc * g0[i];
            if (half == 0 && tid < 64) nval = decay * nval + sc * NV[it2 * 64 + tid];
            m = mn;
          }
          if (nsteps != cc) {
#pragma unroll
            for (int i = 0; i < 8; ++i) p.out[OUT_SC + (sbi * 64 + dq + i) * 64 + e_] = val[i];
            if (half == 0 && tid < 64) p.out[OUT_SN + sbi * 64 + tid] = nval;
            if (half == 0 && tid == 0) p.out[OUT_SM + sbi] = m;
          }
        }
      }
      __syncthreads();
      f32x4 s[4], qc[4], wv[4];
#pragma unroll
      for (int nt = 0; nt < 4; ++nt) { s[nt] = (f32x4){0.f, 0.f, 0.f, 0.f}; qc[nt] = s[nt]; wv[nt] = s[nt]; }
      mma_lds<4, 2>(sQ + w * 16 * LDT, sK, s, lane);
      mma_lds<4, 2>(sQ + w * 16 * LDT, sCt, qc, lane);
      float qn_r;
      {
        float acc = 0.f;
        const bf16_t* qr = sQ + (w * 16 + r) * LDT + q * 16;
#pragma unroll
        for (int i = 0; i < 16; ++i) acc += bf2f(qr[i]) * sn[q * 16 + i];
        acc += __shfl_xor(acc, 16);
        acc += __shfl_xor(acc, 32);
        qn_r = acc;
      }
      float scj[4], denj[4];
#pragma unroll
      for (int j = 0; j < 4; ++j) {
        const int t = w * 16 + q * 4 + j;
        const float btt = sb[t];
        float dl[4];
        float mx = -INFINITY;
#pragma unroll
        for (int nt = 0; nt < 4; ++nt) {
          const int si = nt * 16 + r;
          const bool valid = dir ? (si >= t) : (si <= t);
          dl[nt] = valid ? (btt - sb[si] + sig[si]) : -INFINITY;
          mx = fmaxf(mx, dl[nt]);
        }
        mx = g16_max(mx);
        const float mrow = fmaxf(btt + m0, mx);
        float rs = 0.f;
#pragma unroll
        for (int nt = 0; nt < 4; ++nt) {
          const float wv_ = __expf(dl[nt] - mrow) * s[nt][j];
          rs += wv_;
          sWw[(q * 4 + j) * LDT + nt * 16 + r] = f2bf(wv_);
        }
        rs = g16_sum(rs);
        const float sc = __expf(btt + m0 - mrow);
        const float qn = __shfl(qn_r, q * 4 + j);
        scj[j] = sc;
        denj[j] = fmaxf(fabsf(sc * qn + rs), __expf(-mrow));
      }
      mma_lds<4, 2>(sWw, sVt, wv, lane);
#pragma unroll
      for (int nt = 0; nt < 4; ++nt)
#pragma unroll
        for (int j = 0; j < 4; ++j) hacc[nt][j] += (scj[j] * qc[nt][j] + wv[nt][j]) / denj[j];
    }
    bf16_t* mix = (bf16_t*)(p.ws + OFF_MIX);
#pragma unroll
    for (int j = 0; j < 4; ++j) {
      float ss = 0.f;
#pragma unroll
      for (int nt = 0; nt < 4; ++nt) ss += hacc[nt][j] * hacc[nt][j];
      ss = g16_sum(ss);
      const float rstd = rsqrtf(ss * (1.f / 64.f) + EPS);
      const size_t row = row0 + w * 16 + q * 4 + j;
#pragma unroll
      for (int nt = 0; nt < 4; ++nt) {
        const int e = nt * 16 + r;
        const float om = bf2f(P[row * NP + PC_OM + h * 64 + e]);
        const float sg = 1.f / (1.f + __expf(-om));
        mix[row * 1024 + 512 + h * 64 + e] = f2bf(sg * hacc[nt][j] * rstd * p.mlstm_norm_g[l * 256 + h * 64 + e]);
      }
    }
  }
}

DI void g16_max4(float& a, float& b, float& c, float& d) {
  asm volatile(
      "s_nop 1\n\t"
      "v_max_f32_dpp %0, %0, %0 row_ror:8 row_mask:0xf bank_mask:0xf\n\t"
      "v_max_f32_dpp %1, %1, %1 row_ror:8 row_mask:0xf bank_mask:0xf\n\t"
      "v_max_f32_dpp %2, %2, %2 row_ror:8 row_mask:0xf bank_mask:0xf\n\t"
      "v_max_f32_dpp %3, %3, %3 row_ror:8 row_mask:0xf bank_mask:0xf\n\t"
      "v_max_f32_dpp %0, %0, %0 row_ror:4 row_mask:0xf bank_mask:0xf\n\t"
      "v_max_f32_dpp %1, %1, %1 row_ror:4 row_mask:0xf bank_mask:0xf\n\t"
      "v_max_f32_dpp %2, %2, %2 row_ror:4 row_mask:0xf bank_mask:0xf\n\t"
      "v_max_f32_dpp %3, %3, %3 row_ror:4 row_mask:0xf bank_mask:0xf\n\t"
      "v_max_f32_dpp %0, %0, %0 row_ror:2 row_mask:0xf bank_mask:0xf\n\t"
      "v_max_f32_dpp %1, %1, %1 row_ror:2 row_mask:0xf bank_mask:0xf\n\t"
      "v_max_f32_dpp %2, %2, %2 row_ror:2 row_mask:0xf bank_mask:0xf\n\t"
      "v_max_f32_dpp %3, %3, %3 row_ror:2 row_mask:0xf bank_mask:0xf\n\t"
      "v_max_f32_dpp %0, %0, %0 row_ror:1 row_mask:0xf bank_mask:0xf\n\t"
      "v_max_f32_dpp %1, %1, %1 row_ror:1 row_mask:0xf bank_mask:0xf\n\t"
      "v_max_f32_dpp %2, %2, %2 row_ror:1 row_mask:0xf bank_mask:0xf\n\t"
      "v_max_f32_dpp %3, %3, %3 row_ror:1 row_mask:0xf bank_mask:0xf"
      : "+v"(a), "+v"(b), "+v"(c), "+v"(d));
}

constexpr unsigned CT0 = 0xE0331000u, CT1 = 0xF0401101u, CT2 = 0xFF411202u, CT3 = 0xFF421303u, CT4 = 0xFF501404u, CT5 = 0xFF511505u, CT6 = 0xFF601606u, CT7 = 0xFF611707u, CT8 = 0xFF702008u, CT9 = 0xFF712109u, CT10 = 0xFF80220Au, CT11 = 0xFF90230Bu, CT12 = 0xFFA0240Cu, CT13 = 0xFFB0300Du, CT14 = 0xFFC0310Eu, CT15 = 0xFFD0320Fu;
struct TopE { float s; int i; };

DI void phase_scores(const Params& p, int l, char* smem) {
  bf16_t* sA = (bf16_t*)smem;
  bf16_t* sB = sA + 64 * LDT;
  TopE* sTop = (TopE*)(sB + 128 * LDT);
  const int tid = otid(), lane = tid & 63, w = tid >> 6, r = lane & 15, q = lane >> 4;
  const bf16_t* QP = (const bf16_t*)(p.ws + OFF_QP);
  const bf16_t* KB = (const bf16_t*)(p.ws + OFF_KEYS);
  int* EIDX = (int*)(p.ws + OFF_EIDX);
  float* EG = (float*)(p.ws + OFF_EGATE);
  u32x4 pa[2], pb[4];
  const int prow = tid >> 2, pd = (tid & 3) * 16;
#define SC_LOAD(ITEM, C, KH) { \
    const bf16_t* qsrc_ = QP + (size_t)(((ITEM) >> 3) * 64 + prow) * 2048 + ((ITEM) & 7) * 256 + (C) * 128 + (KH) * 64 + pd; \
    const bf16_t* ksrc_ = KB + ((size_t)((l * 8 + ((ITEM) & 7)) * 2 + (C)) * 128 + prow) * 128 + (KH) * 64 + pd; \
    pa[0] = *(const u32x4*)(qsrc_); pa[1] = *(const u32x4*)(qsrc_ + 8); \
    pb[0] = *(const u32x4*)(ksrc_); pb[1] = *(const u32x4*)(ksrc_ + 8); \
    pb[2] = *(const u32x4*)(ksrc_ + 64 * 128); pb[3] = *(const u32x4*)(ksrc_ + 64 * 128 + 8); }
  if ((int)blockIdx.x < 1024) SC_LOAD((int)blockIdx.x, 0, 0)
  for (int item = blockIdx.x; item < 1024; item += gridDim.x) {
    const int tt = item >> 3, hh = item & 7;
    const int row0 = tt * 64;
#pragma unroll 1
    for (int c = 0; c < 2; ++c) {
      f32x4 acc[8];
#pragma unroll
      for (int nt = 0; nt < 8; ++nt) acc[nt] = (f32x4){0.f, 0.f, 0.f, 0.f};
#pragma unroll 1
      for (int kh = 0; kh < 2; ++kh) {
        __syncthreads();
        *(u32x4*)(sA + prow * LDT + pd) = pa[0]; *(u32x4*)(sA + prow * LDT + pd + 8) = pa[1];
        *(u32x4*)(sB + prow * LDT + pd) = pb[0]; *(u32x4*)(sB + prow * LDT + pd + 8) = pb[1];
        *(u32x4*)(sB + (64 + prow) * LDT + pd) = pb[2]; *(u32x4*)(sB + (64 + prow) * LDT + pd + 8) = pb[3];
        __syncthreads();
        {
          const int st = c * 2 + kh;
          if (st < 3) { const int cn = (st + 1) >> 1, kn = (st + 1) & 1; SC_LOAD(item, cn, kn) }
          else if (item + (int)gridDim.x < 1024) { SC_LOAD(item + (int)gridDim.x, 0, 0) }
        }
        mma_lds<8, 2>(sA + w * 16 * LDT, sB, acc, lane);
      }
      {
        float v[4][8];
#pragma unroll
        for (int j = 0; j < 4; ++j)
#pragma unroll
          for (int nt = 0; nt < 8; ++nt)
            v[j][nt] = __uint_as_float((__float_as_uint(acc[nt][j]) & ~0x7Fu) | (unsigned)(127 - (nt * 16 + r)));
#define CE_(j, x, y) { const float hi_ = fmaxf(v[j][x], v[j][y]), lo_ = fminf(v[j][x], v[j][y]); v[j][x] = hi_; v[j][y] = lo_; }
#pragma unroll
        for (int j = 0; j < 4; ++j) {
          CE_(j, 0, 1) CE_(j, 2, 3) CE_(j, 4, 5) CE_(j, 6, 7)
          CE_(j, 0, 2) CE_(j, 1, 3) CE_(j, 4, 6) CE_(j, 5, 7)
          CE_(j, 1, 2) CE_(j, 5, 6) CE_(j, 0, 4) CE_(j, 3, 7)
          CE_(j, 1, 5) CE_(j, 2, 6)
          CE_(j, 1, 4) CE_(j, 3, 6)
          CE_(j, 2, 4) CE_(j, 3, 5)
          CE_(j, 3, 4)
        }
#undef CE_
        float myK[4] = {0.f, 0.f, 0.f, 0.f};
#pragma unroll 2
        for (int itk = 0; itk < 16; ++itk) {
          const bool rec = (r == itk);
          float gmx[4] = {v[0][0], v[1][0], v[2][0], v[3][0]};
          g16_max4(gmx[0], gmx[1], gmx[2], gmx[3]);
#pragma unroll
          for (int j = 0; j < 4; ++j) {
            const float gm = gmx[j];
            const bool win = (v[j][0] == gm);
#pragma unroll
            for (int s2 = 0; s2 < 7; ++s2) v[j][s2] = win ? v[j][s2 + 1] : v[j][s2];
            v[j][7] = win ? -INFINITY : v[j][7];
            myK[j] = rec ? gm : myK[j];
          }
        }
#pragma unroll
        for (int j = 0; j < 4; ++j) {
          TopE te; te.s = __uint_as_float(__float_as_uint(myK[j]) & ~0x7Fu); te.i = 127 - (int)(__float_as_uint(myK[j]) & 0x7Fu);
          sTop[((w * 16 + q * 4 + j) * 2 + c) * 16 + r] = te;
        }
      }
    }
    __syncthreads();
    const unsigned ctab = (r == 0) ? CT0 : (r == 1) ? CT1 : (r == 2) ? CT2 : (r == 3) ? CT3 : (r == 4) ? CT4 : (r == 5) ? CT5 : (r == 6) ? CT6 : (r == 7) ? CT7 :
                          (r == 8) ? CT8 : (r == 9) ? CT9 : (r == 10) ? CT10 : (r == 11) ? CT11 : (r == 12) ? CT12 : (r == 13) ? CT13 : (r == 14) ? CT14 : CT15;
    {
      float cv[4][4];
#pragma unroll
      for (int j = 0; j < 4; ++j) {
        const int rl = w * 16 + q * 4 + j;
#pragma unroll
        for (int sl = 0; sl < 4; ++sl) {
          const unsigned code = (ctab >> (8 * sl)) & 0xFFu;
          const bool valid = code != 0xFFu;
          const unsigned cc = valid ? code : 0u;
          const float sum = sTop[(rl * 2 + 0) * 16 + (cc >> 4)].s + sTop[(rl * 2 + 1) * 16 + (cc & 15u)].s;
          cv[j][sl] = valid ? __uint_as_float((__float_as_uint(sum) & ~0xFFu) | (255u - code)) : -INFINITY;
        }
#define CE2_(x, y) { const float hi_ = fmaxf(cv[j][x], cv[j][y]), lo_ = fminf(cv[j][x], cv[j][y]); cv[j][x] = hi_; cv[j][y] = lo_; }
        CE2_(0, 1) CE2_(2, 3) CE2_(0, 2) CE2_(1, 3) CE2_(1, 2)
#undef CE2_
      }
      float myK[4] = {0.f, 0.f, 0.f, 0.f};
#pragma unroll 2
      for (int itk = 0; itk < 16; ++itk) {
        const bool rec = (r == itk);
        float gmx[4] = {cv[0][0], cv[1][0], cv[2][0], cv[3][0]};
        g16_max4(gmx[0], gmx[1], gmx[2], gmx[3]);
#pragma unroll
        for (int j = 0; j < 4; ++j) {
          const bool win = (cv[j][0] == gmx[j]);
          cv[j][0] = win ? cv[j][1] : cv[j][0];
          cv[j][1] = win ? cv[j][2] : cv[j][1];
          cv[j][2] = win ? cv[j][3] : cv[j][2];
          cv[j][3] = win ? -INFINITY : cv[j][3];
          myK[j] = rec ? gmx[j] : myK[j];
        }
      }
#pragma unroll
      for (int j = 0; j < 4; ++j) {
        const int rl = w * 16 + q * 4 + j;
        const int pidx = 255 - (int)(__float_as_uint(myK[j]) & 0xFFu);
        const TopE e0 = sTop[(rl * 2 + 0) * 16 + (pidx >> 4)];
        const TopE e1 = sTop[(rl * 2 + 1) * 16 + (pidx & 15)];
        const float myS = e0.s + e1.s;
        const float mx = g16_max(myS);
        const float ex = __expf(myS - mx);
        const float sm = g16_sum(ex);
        const size_t o = (size_t)(row0 + rl) * 128 + hh * 16 + r;
        EIDX[o] = e0.i * 128 + e1.i;
        EG[o] = ex / sm;
      }
    }
  }
}

#undef SC_LOAD
DI void phase_experts(const Params& p, int l, char* smem) {
  const int tid = otid(), lane = tid & 63, w = tid >> 6, sub = lane & 15, gq = lane >> 4;
  float* sWt = (float*)smem + w * 384;
  int* sIdx = (int*)(sWt + 128);
  float* sG = sWt + 256;
  const bf16_t* H = (const bf16_t*)(p.ws + OFF_H);
  const unsigned char* U = (const unsigned char*)(p.ws + OFF_U16) + (size_t)l * 16384 * 1024;
  const unsigned char* V = (const unsigned char*)(p.ws + OFF_V16) + (size_t)l * 16384 * 1024;
  const int* EIDX = (const int*)(p.ws + OFF_EIDX);
  const float* EG = (const float*)(p.ws + OFF_EGATE);
  float* X = (float*)(p.ws + OFF_X);
  const float* mod = (const float*)(p.ws + OFF_MOD);
  for (int tok = blockIdx.x * 4 + w; tok < T; tok += gridDim.x * 4) {
    sIdx[lane] = EIDX[(size_t)tok * 128 + lane]; sIdx[lane + 64] = EIDX[(size_t)tok * 128 + 64 + lane];
    sG[lane] = EG[(size_t)tok * 128 + lane]; sG[lane + 64] = EG[(size_t)tok * 128 + 64 + lane];
    unsigned hvs[32];
#pragma unroll
    for (int i = 0; i < 4; ++i) {
      const uint4 t0 = *(const uint4*)(H + (size_t)tok * 1024 + i * 256 + sub * 16);
      const uint4 t1 = *(const uint4*)(H + (size_t)tok * 1024 + i * 256 + sub * 16 + 8);
      hvs[i * 8 + 0] = t0.x; hvs[i * 8 + 1] = t0.y; hvs[i * 8 + 2] = t0.z; hvs[i * 8 + 3] = t0.w;
      hvs[i * 8 + 4] = t1.x; hvs[i * 8 + 5] = t1.y; hvs[i * 8 + 6] = t1.z; hvs[i * 8 + 7] = t1.w;
    }
#pragma unroll 4
    for (int it = 0; it < 32; ++it) {
      const int k = it * 4 + gq;
      const unsigned char* ur = U + (size_t)sIdx[k] * 1024 + sub * 16;
      unsigned uvs[16];
#pragma unroll
      for (int i = 0; i < 4; ++i) {
        const uint4 t = *(const uint4*)(ur + 256 * i);
        uvs[i * 4 + 0] = t.x; uvs[i * 4 + 1] = t.y; uvs[i * 4 + 2] = t.z; uvs[i * 4 + 3] = t.w;
      }
      float acc = 0.f;
#pragma unroll
      for (int i = 0; i < 16; ++i) {
        const bf16x2_t lo = __builtin_amdgcn_cvt_scalef32_pk_bf16_fp8((int)uvs[i], 1.0f, false);
        const bf16x2_t hi = __builtin_amdgcn_cvt_scalef32_pk_bf16_fp8((int)uvs[i], 1.0f, true);
        acc = __builtin_amdgcn_fdot2_f32_bf16(lo, __builtin_bit_cast(bf16x2_t, hvs[i * 2]), acc, false);
        acc = __builtin_amdgcn_fdot2_f32_bf16(hi, __builtin_bit_cast(bf16x2_t, hvs[i * 2 + 1]), acc, false);
      }
      acc = g16_sum(acc) * (1.f / 256.f);
      const float ge = 0.5f * acc * (1.f + erff(acc * 0.70710678118654752f));
      if (sub == 0) sWt[k] = ge * sG[k] * (1.f / 64.f);
    }
    float o[16];
#pragma unroll
    for (int i = 0; i < 16; ++i) o[i] = 0.f;
#pragma unroll 16
    for (int k = 0; k < 128; ++k) {
      const uint4 t = *(const uint4*)(V + (size_t)sIdx[k] * 1024 + lane * 16);
      const float wk = sWt[k];
      const unsigned tw[4] = {t.x, t.y, t.z, t.w};
#pragma unroll
      for (int d = 0; d < 4; ++d) {
        const f32x2 lo = __builtin_amdgcn_cvt_pk_f32_fp8((int)tw[d], false);
        const f32x2 hi = __builtin_amdgcn_cvt_pk_f32_fp8((int)tw[d], true);
        o[d * 4 + 0] += wk * lo.x; o[d * 4 + 1] += wk * lo.y; o[d * 4 + 2] += wk * hi.x; o[d * 4 + 3] += wk * hi.y;
      }
    }
    const int ci = tok_ci(tok);
    float xv[16], g2[16];
    load_row16(X + (size_t)tok * 1024, lane, xv);
    load_row16(mod + (size_t)(l * 3 + ci) * 6144 + 5120, lane, g2);
#pragma unroll
    for (int i = 0; i < 16; ++i) xv[i] += g2[i] * o[i];
    if (l == 0) {
      store_row16(X + (size_t)tok * 1024, lane, xv);
      const float* md = mod + (size_t)(3 + ci) * 6144;
      norm_mod_emit(xv, lane, p.norm1_g + 1024, md + 1024, md, (bf16_t*)(p.ws + OFF_H) + (size_t)tok * 1024,
                    (const float*)(p.ws + OFF_WGT) + (size_t)16 * 1024, (float*)(p.ws + OFF_GATES) + (size_t)tok * 16);
    } else {
      float ss = 0.f;
#pragma unroll
      for (int i = 0; i < 16; ++i) ss += xv[i] * xv[i];
      ss = wave_sum(ss);
      const float rstd = rsqrtf(ss * (1.f / 1024.f) + EPS);
      float gv[16];
      load_row16(p.final_norm_g, lane, gv);
#pragma unroll
      for (int i = 0; i < 16; ++i) xv[i] = xv[i] * rstd * gv[i];
      store_row16(p.out + (size_t)tok * 1024, lane, xv);
    }
  }
}


#define XB_TMO      128
#define XB_XCNT(j)  (256  + 64 * (j))
#define XB_XSUB(j)  (1280 + 64 * (j))
#define XB_XGEN(j)  (2304 + 64 * (j))
#define XB_TOP      3328
#define XB_TOPGEN   3392
#define XCD_BAR_WORDS 3456
#define XB_SPIN_CAP (1u << 18)
#define LAS __attribute__((address_space(3)))

__device__ __forceinline__ unsigned xb_ld(unsigned* p)              { return __hip_atomic_load(p, __ATOMIC_RELAXED, __HIP_MEMORY_SCOPE_AGENT); }
__device__ __forceinline__ unsigned xb_add(unsigned* p, unsigned v) { return __hip_atomic_fetch_add(p, v, __ATOMIC_RELAXED, __HIP_MEMORY_SCOPE_AGENT); }
__device__ __forceinline__ unsigned xb_xcc_id() { return (unsigned)__builtin_amdgcn_s_getreg((3 << 11) | 20) & 0xFu; }
#define XB_SPIN(cond, bar) do { unsigned _sp = 0; while (cond) { __builtin_amdgcn_s_sleep(1); \
    if ((++_sp & 255u) == 0u) { if (xb_ld(&(bar)[XB_TMO])) break; if (_sp > XB_SPIN_CAP) { atomicAdd(&(bar)[XB_TMO], 1u); break; } } } } while (0)

struct XcdBarrier {
    unsigned* bar; unsigned x;
    volatile LAS unsigned* st;
};

__device__ __forceinline__ XcdBarrier xcd_barrier_post(unsigned* bar, volatile LAS unsigned* st) {
    XcdBarrier b; b.bar = bar; b.x = xb_xcc_id(); b.st = st;
    if (threadIdx.x == 0) (void)xb_add(&bar[XB_XCNT(b.x)], 1u);
    return b;
}
__device__ __forceinline__ void xcd_barrier_complete(unsigned* bar, unsigned x, unsigned& nloc, unsigned& nx) {
    const unsigned G = gridDim.x * gridDim.y * gridDim.z;
    unsigned sum, cnt, mine, sp = 0u;
    for (;;) {
        sum = 0u; cnt = 0u; mine = 0u;
#pragma unroll
        for (unsigned j = 0; j < 16; ++j) { const unsigned c = xb_ld(&bar[XB_XCNT(j)]); sum += c; cnt += (c > 0u) ? 1u : 0u; mine = (j == x) ? c : mine; }
        if (sum == G) break;
        __builtin_amdgcn_s_sleep(1);
        if ((++sp & 255u) == 0u) { if (xb_ld(&bar[XB_TMO])) break; if (sp > XB_SPIN_CAP) { atomicAdd(&bar[XB_TMO], 1u); break; } }
    }
    nloc = mine > 0u ? mine : 1u; nx = cnt > 0u ? cnt : 1u;
}

__device__ __forceinline__ void xcd_barrier(const XcdBarrier& b) {
    asm volatile("s_waitcnt vmcnt(0)" ::: "memory");
    __syncthreads();
    if (threadIdx.x == 0) {
        unsigned* bar = b.bar;
        __builtin_amdgcn_s_waitcnt(0);
        unsigned nloc = b.st[0], nx = b.st[1];
        if (nloc == 0u) { xcd_barrier_complete(bar, b.x, nloc, nx); b.st[0] = nloc; b.st[1] = nx; }
        const unsigned old = xb_add(&bar[XB_XSUB(b.x)], 1u);
        const unsigned gen = old / nloc;
        if (old + 1u == (gen + 1u) * nloc) {
            __builtin_amdgcn_fence(__ATOMIC_RELEASE, "agent");
            asm volatile("s_waitcnt vmcnt(0)" ::: "memory");
            const unsigned og = xb_add(&bar[XB_TOP], 1u);
            const unsigned tg = og / nx;
            if (og + 1u == (tg + 1u) * nx) xb_add(&bar[XB_TOPGEN], 1u);
            else XB_SPIN(xb_ld(&bar[XB_TOPGEN]) == tg, bar);
            __builtin_amdgcn_fence(__ATOMIC_ACQUIRE, "agent");
            xb_add(&bar[XB_XGEN(b.x)], 1u);
            asm volatile("s_waitcnt vmcnt(0)" ::: "memory");
        } else {
            XB_SPIN(xb_ld(&bar[XB_XGEN(b.x)]) == gen, bar);
            __builtin_amdgcn_fence(__ATOMIC_ACQUIRE, "agent");
            asm volatile("s_waitcnt vmcnt(0)" ::: "memory");
        }
    }
    __syncthreads();
}


template <int CTRL> DI float dpp_mov(float v) {
  return __builtin_bit_cast(float, __builtin_amdgcn_update_dpp(0, __builtin_bit_cast(int, v), CTRL, 0xF, 0xF, false));
}
DI float g8_sum(float v) { v += dpp_mov<0xB1>(v); v += dpp_mov<0x4E>(v); v += dpp_mov<0x141>(v); return v; }

DI void team_info(const Params& p, const int* s_team, int& rank, int& nloc, int& pi, int& np) {
  unsigned* bar = (unsigned*)(p.ws + OFF_BAR);
  const unsigned x = xb_xcc_id();
  int np_ = 0, pi_ = 0, nl = 1;
#pragma unroll
  for (unsigned j = 0; j < 16; ++j) {
    const unsigned c = xb_ld(&bar[XB_XCNT(j)]);
    if (c > 0u) { np_ += 1; if (j < x) pi_ += 1; }
    if (j == x) nl = (int)c;
  }
  rank = s_team[0]; nloc = nl > 0 ? nl : 1; pi = pi_; np = np_ > 0 ? np_ : 1;
}

DI void phase_expA(const Params& p, int l, char* smem, const int* s_team) {
  const int tid = otid(), lane = tid & 63, w = __builtin_amdgcn_readfirstlane(tid >> 6), j8 = lane & 7, g = lane >> 3;
  int rank, nloc, pi, np;
  team_info(p, s_team, rank, nloc, pi, np);
  int* sIdx = (int*)smem + w * 128;
  const bf16_t* H = (const bf16_t*)(p.ws + OFF_H);
  const int* EIDX = (const int*)(p.ws + OFF_EIDX);
  float* PART = (float*)(p.ws + OFF_QP);
  const int stride = nloc * 4;
  for (int s = pi; s < 8; s += np) {
    const unsigned char* Us = (const unsigned char*)(p.ws + OFF_U16) + (((size_t)(l * 8 + s) * 16384) << 7);
    int tok = rank * 4 + w;
    int e0n = 0, e1n = 0;
    uint4 h0n = make_uint4(0, 0, 0, 0), h1n = h0n;
    if (tok < T) {
      e0n = EIDX[(size_t)tok * 128 + lane]; e1n = EIDX[(size_t)tok * 128 + 64 + lane];
      h0n = *(const uint4*)(H + (size_t)tok * 1024 + s * 128 + j8 * 16);
      h1n = *(const uint4*)(H + (size_t)tok * 1024 + s * 128 + j8 * 16 + 8);
    }
    for (; tok < T; tok += stride) {
      sIdx[lane] = e0n; sIdx[lane + 64] = e1n;
      const unsigned hv[8] = {h0n.x, h0n.y, h0n.z, h0n.w, h1n.x, h1n.y, h1n.z, h1n.w};
      uint4 tq[16];
#pragma unroll
      for (int it = 0; it < 16; ++it) tq[it] = *(const uint4*)(Us + (((unsigned)sIdx[it * 8 + g] << 7) + (unsigned)(j8 * 16)));
      const int nt = tok + stride;
      if (nt < T) {
        e0n = EIDX[(size_t)nt * 128 + lane]; e1n = EIDX[(size_t)nt * 128 + 64 + lane];
        h0n = *(const uint4*)(H + (size_t)nt * 1024 + s * 128 + j8 * 16);
        h1n = *(const uint4*)(H + (size_t)nt * 1024 + s * 128 + j8 * 16 + 8);
      }
      float my0 = 0.f, my1 = 0.f;
#pragma unroll
      for (int it = 0; it < 16; ++it) {
        const unsigned tw[4] = {tq[it].x, tq[it].y, tq[it].z, tq[it].w};
        float acc = 0.f;
#pragma unroll
        for (int d = 0; d < 4; ++d) {
          const bf16x2_t lo = __builtin_amdgcn_cvt_scalef32_pk_bf16_fp8((int)tw[d], 1.0f, false);
          const bf16x2_t hi = __builtin_amdgcn_cvt_scalef32_pk_bf16_fp8((int)tw[d], 1.0f, true);
          acc = __builtin_amdgcn_fdot2_f32_bf16(lo, __builtin_bit_cast(bf16x2_t, hv[d * 2]), acc, false);
          acc = __builtin_amdgcn_fdot2_f32_bf16(hi, __builtin_bit_cast(bf16x2_t, hv[d * 2 + 1]), acc, false);
        }
        acc = g8_sum(acc);
        if ((it & 7) == j8) { if (it < 8) my0 = acc; else my1 = acc; }
      }
      float* pr = PART + ((size_t)s * T + tok) * 128;
      pr[j8 * 8 + g] = my0;
      pr[(j8 + 8) * 8 + g] = my1;
    }
  }
}

DI void phase_expW(const Params& p) {
  const int tid = otid(), lane = tid & 63;
  const int gw = blockIdx.x * 4 + __builtin_amdgcn_readfirstlane(tid >> 6), nw = gridDim.x * 4;
  float* EG = (float*)(p.ws + OFF_EGATE);
  const float* PART = (const float*)(p.ws + OFF_QP);
  for (int tok = gw; tok < T; tok += nw) {
#pragma unroll
    for (int kk = 0; kk < 2; ++kk) {
      const int k = lane + 64 * kk;
      float pv[8];
#pragma unroll
      for (int s2 = 0; s2 < 8; ++s2) pv[s2] = PART[((size_t)s2 * T + tok) * 128 + k];
      float a = ((pv[0] + pv[1]) + (pv[2] + pv[3])) + ((pv[4] + pv[5]) + (pv[6] + pv[7]));
      a *= (1.f / 256.f);
      const float ge = 0.5f * a * (1.f + erff(a * 0.70710678118654752f));
      EG[(size_t)tok * 128 + k] = ge * EG[(size_t)tok * 128 + k] * (1.f / 64.f);
    }
  }
}

DI void phase_expB(const Params& p, int l, char* smem, const int* s_team) {
  const int tid = otid(), lane = tid & 63, w = __builtin_amdgcn_readfirstlane(tid >> 6), j8 = lane & 7, g = lane >> 3;
  int rank, nloc, pi, np;
  team_info(p, s_team, rank, nloc, pi, np);
  float* sW = (float*)smem + w * 256;
  int* sIdx = (int*)(sW + 128);
  const int* EIDX = (const int*)(p.ws + OFF_EIDX);
  const float* EW = (const float*)(p.ws + OFF_EGATE);
  float* X = (float*)(p.ws + OFF_X);
  const float* mod = (const float*)(p.ws + OFF_MOD);
  const int stride = nloc * 4;
  const int dsub = j8 * 16 + ((lane & 32) ? 8 : 0) + ((lane & 16) ? 4 : 0) + ((lane & 8) ? 2 : 0);
  for (int s = pi; s < 8; s += np) {
    const unsigned char* Vs = (const unsigned char*)(p.ws + OFF_V16) + (((size_t)(l * 8 + s) * 16384) << 7);
    int tok = rank * 4 + w;
    float wn0 = 0.f, wn1 = 0.f;
    int en0 = 0, en1 = 0;
    if (tok < T) {
      wn0 = EW[(size_t)tok * 128 + lane]; wn1 = EW[(size_t)tok * 128 + 64 + lane];
      en0 = EIDX[(size_t)tok * 128 + lane]; en1 = EIDX[(size_t)tok * 128 + 64 + lane];
    }
    for (; tok < T; tok += stride) {
      sW[lane] = wn0; sW[lane + 64] = wn1; sIdx[lane] = en0; sIdx[lane + 64] = en1;
      uint4 tq[16];
#pragma unroll
      for (int it = 0; it < 16; ++it) tq[it] = *(const uint4*)(Vs + (((unsigned)sIdx[it * 8 + g] << 7) + (unsigned)(j8 * 16)));
      const int dim = s * 128 + dsub;
      const float2 g2 = *(const float2*)(mod + (size_t)(l * 3 + tok_ci(tok)) * 6144 + 5120 + dim);
      float2* xp = (float2*)(X + (size_t)tok * 1024 + dim);
      float2 xv = *xp;
      const int nt = tok + stride;
      if (nt < T) {
        wn0 = EW[(size_t)nt * 128 + lane]; wn1 = EW[(size_t)nt * 128 + 64 + lane];
        en0 = EIDX[(size_t)nt * 128 + lane]; en1 = EIDX[(size_t)nt * 128 + 64 + lane];
      }
      f32x2 o2[8];
#pragma unroll
      for (int i = 0; i < 8; ++i) o2[i] = (f32x2){0.f, 0.f};
#pragma unroll
      for (int it = 0; it < 16; ++it) {
        const float wk = sW[it * 8 + g];
        const f32x2 wk2 = (f32x2){wk, wk};
        const unsigned tw[4] = {tq[it].x, tq[it].y, tq[it].z, tq[it].w};
#pragma unroll
        for (int d = 0; d < 4; ++d) {
          const f32x2 lo = __builtin_amdgcn_cvt_pk_f32_fp8((int)tw[d], false);
          const f32x2 hi = __builtin_amdgcn_cvt_pk_f32_fp8((int)tw[d], true);
          o2[d * 2] = lo * wk2 + o2[d * 2];
          o2[d * 2 + 1] = hi * wk2 + o2[d * 2 + 1];
        }
      }
      float o[16];
#pragma unroll
      for (int i = 0; i < 8; ++i) { o[2 * i] = o2[i].x; o[2 * i + 1] = o2[i].y; }
      typedef unsigned u32x2_ __attribute__((ext_vector_type(2)));
#pragma unroll
      for (int j = 0; j < 8; ++j) {
        const u32x2_ sw = __builtin_amdgcn_permlane32_swap(__float_as_uint(o[j]), __float_as_uint(o[j + 8]), false, false);
        o[j] = __uint_as_float(sw.x) + __uint_as_float(sw.y);
      }
#pragma unroll
      for (int j = 0; j < 4; ++j) {
        const u32x2_ sw = __builtin_amdgcn_permlane16_swap(__float_as_uint(o[j]), __float_as_uint(o[j + 4]), false, false);
        o[j] = __uint_as_float(sw.x) + __uint_as_float(sw.y);
      }
      {
        const bool up = lane & 8;
#pragma unroll
        for (int j = 0; j < 2; ++j) { const float send = up ? o[j] : o[j + 2], keep = up ? o[j + 2] : o[j]; o[j] = keep + dpp_ror<8>(send); }
      }
      xv.x += g2.x * o[0]; xv.y += g2.y * o[1];
      *xp = xv;
    }
  }
}

#define PH(k, call) if (p.phase_lo <= (k) && (k) <= p.phase_hi) { if ((k) > p.phase_lo) { if (p.phase_hi == 0x7fffffff) cg::this_grid().sync(); xcd_barrier(xb); } call; }
#define LAYER(l, base) \
  PH(base + 1, (phase_gemm<0>(p, l, (const bf16_t*)(p.ws + OFF_H), (const bf16_t*)(p.ws + OFF_WINT) + (size_t)l * 2048 * 1024, 2048, smem), deferred_convert(p, l, 256, 6, false, smem))) \
  PH(base + 2, phase_mixers(p, l, smem)) \
  PH(base + 4, (phase_mlstm_out(p, l, smem), deferred_convert(p, l, 512, 8, false, smem))) \
  PH(base + 5, (phase_gemm<1>(p, l, (const bf16_t*)(p.ws + OFF_MIX), (const bf16_t*)(p.ws + OFF_WOUTT) + (size_t)l * 1024 * 1024, 1024, smem), deferred_convert(p, l, 512, 10, false, smem))) \
  PH(base + 6, phase_norm(p, l, 1)) \
  PH(base + 7, (phase_gemm<2>(p, l, (const bf16_t*)(p.ws + OFF_H), (const bf16_t*)(p.ws + OFF_WQT) + (size_t)l * 2048 * 1024, 2048, smem), deferred_convert(p, l, 256, 6, false, smem))) \
  PH(base + 8, (phase_scores(p, l, smem), deferred_convert(p, l, 256, 12, false, smem), deferred_convert(p, l, 0, 4, true, smem))) \
  PH(base + 9, phase_expA(p, l, smem, s_team)) \
  PH(base + 10, phase_expW(p)) \
  PH(base + 11, phase_expB(p, l, smem, s_team)) \
  PH(base + 12, phase_norm(p, l + 1, l == 0 ? 2 : 3))

constexpr int N_PHASES = 26;
__global__ void __launch_bounds__(256, 3) fwd_megakernel(Params p) {
  __shared__ __attribute__((aligned(16))) char smem[SMEM_BYTES];
  __shared__ uint4 xb_words;
  __shared__ int s_team[4];
  if (threadIdx.x == 0) {
    xb_words = make_uint4(0u, 0u, 0u, 0u);
    s_team[0] = (int)atomicAdd((unsigned*)(p.ws + OFF_BAR) + 3584 + xb_xcc_id() * 32, 1u);
  }
  __syncthreads();
  XcdBarrier xb = xcd_barrier_post((unsigned*)(p.ws + OFF_BAR), (volatile LAS unsigned*)&xb_words);
  PH(0, phase_prologue(p, smem))
  PH(1, phase_norm(p, 0, 0))
  LAYER(0, 1)
  LAYER(1, 13)
}

extern "C" void kernel_launch(void* const* d_in, const int* in_sizes, int n_in, void* d_out, int out_size, void* d_ws, size_t ws_size,
                              hipStream_t stream) {
  Params p{};
  const float** f = (const float**)&p;
  for (int i = 0; i < 25; ++i) f[i] = (const float*)d_in[i];
  p.out = (float*)d_out;
  p.ws = (char*)d_ws;
  static int grid_blocks = 0;
  if (!grid_blocks) {
    int dev = 0, cus = 0, per_cu = 0;
    hipGetDevice(&dev);
    hipDeviceGetAttribute(&cus, hipDeviceAttributeMultiprocessorCount, dev);
    hipOccupancyMaxActiveBlocksPerMultiprocessor(&per_cu, fwd_megakernel, 256, 0);
    if (per_cu > 3) per_cu = 3;
    if (per_cu < 1) per_cu = 1;
    grid_blocks = cus * per_cu;
  }
#if MULTI_LAUNCH
  for (int ph = 0; ph < N_PHASES; ++ph) {
    p.phase_lo = ph; p.phase_hi = ph;
    hipLaunchKernelGGL(fwd_megakernel, dim3(grid_blocks), dim3(256), 0, stream, p);
  }
#else
  p.phase_lo = 0; p.phase_hi = N_PHASES - 1;
  hipMemsetAsync((char*)d_ws + OFF_BAR, 0, 32768, stream);
  void* args[] = {&p};
  hipError_t e = hipLaunchCooperativeKernel((void*)fwd_megakernel, dim3(grid_blocks), dim3(256), args, 0, stream);
  if (e != hipSuccess) fprintf(stderr, "cooperative launch failed: %s (grid %d)\n", hipGetErrorString(e), grid_blocks);
#endif
}
```
